# Optimizing an MI355X kernel written in HIP

```python
import jax, jax.numpy as jnp
from jax import lax
import numpy as np

D_MODEL = 1024
BATCH = 2
SEQ = 16384
DEPTH = 1
DEC_BATCH = 16
DEC_SEQ = 64
PAST_LEN = 4096

CHUNK = 64
D_PLE = 256
D_FF = 2816
CONV_CH = 1024
CONV_WIDTH = 31
SSD_HEADS = 16
SSD_HEAD_DIM = 64
SSD_INNER = SSD_HEADS * SSD_HEAD_DIM
SSD_GROUPS = 2
SSD_STATE = 128
SSD_CONV_WIDTH = 4
SSD_CONV_DIM = SSD_INNER + 2 * SSD_GROUPS * SSD_STATE
MIX_WIDTH = CONV_CH + SSD_INNER
IN_PROJ = 2 * CONV_CH + SSD_INNER + SSD_CONV_DIM + SSD_HEADS
EPS = 1e-6

kernel_name = "hybrid_conformer_ssd_streaming_step"


def rms_norm(x, g):
    xf = x.astype(jnp.float32)
    y = xf * lax.rsqrt(jnp.mean(xf * xf, axis=-1, keepdims=True) + EPS)
    return (y * g.astype(jnp.float32)).astype(x.dtype)


def layer_norm(x, g, b):
    xf = x.astype(jnp.float32)
    mu = jnp.mean(xf, axis=-1, keepdims=True)
    xc = xf - mu
    y = xc * lax.rsqrt(jnp.mean(xc * xc, axis=-1, keepdims=True) + EPS)
    return (y * g.astype(jnp.float32) + b.astype(jnp.float32)).astype(x.dtype)


def swiglu_ffn(x, w_gate, w_up, w_down):
    return (jax.nn.silu(x @ w_gate) * (x @ w_up)) @ w_down


def causal_dwconv(x_pad, w, b):
    c = x_pad.shape[-1]
    y = lax.conv_general_dilated(x_pad, w[:, None, :].astype(x_pad.dtype), (1,), 'VALID',
                                 dimension_numbers=('NWC', 'WIO', 'NWC'),
                                 feature_group_count=c)
    return y + b.astype(x_pad.dtype)


def ssd_chunk_step(S, inp, A):
    x, dt, B, C = inp
    L = x.shape[1]
    acum = jnp.cumsum(dt * A, axis=1)
    causal = jnp.tril(jnp.ones((L, L), dtype=bool))[None, :, :, None, None]
    diff = acum[:, :, None] - acum[:, None, :]
    decay = jnp.where(causal, jnp.exp(jnp.where(causal, diff, 0.0)), 0.0)
    cb = jnp.einsum('btgn,bsgn->btsg', C, B)
    w = cb[..., None] * decay * dt[:, None]
    y = jnp.einsum('btsgj,bsgjp->btgjp', w, x)
    y = y + jnp.einsum('btgn,bgjpn->btgjp', C, S) * jnp.exp(acum)[..., None]
    w_end = jnp.exp(acum[:, -1:] - acum) * dt
    S_new = (S * jnp.exp(acum[:, -1])[..., None, None]
             + jnp.einsum('bsgj,bsgn,bsgjp->bgjpn', w_end, B, x))
    return S_new, y


def ssd_scan(x, dt, A, B, C, S0):
    b, T = x.shape[0], x.shape[1]
    L = min(CHUNK, T)
    nc = T // L

    def to_blocks(a):
        return jnp.moveaxis(a.reshape((b, nc, L) + a.shape[2:]), 1, 0)

    S, ys = lax.scan(lambda s, inp: ssd_chunk_step(s, inp, A), S0,
                     (to_blocks(x), to_blocks(dt), to_blocks(B), to_blocks(C)))
    y = jnp.moveaxis(ys, 0, 1).reshape(x.shape)
    return y, S


def hybrid_mixer(u, conv_buf, xbc_buf, ssm, conv_dw_w, conv_dw_b, conv_ln_g, conv_ln_b,
                 ssd_conv_w, ssd_conv_b, ssd_dt_bias, ssd_A_log, ssd_D, ssd_norm):
    b, T, _ = u.shape
    f32 = jnp.float32
    G, J, P, N = SSD_GROUPS, SSD_HEADS // SSD_GROUPS, SSD_HEAD_DIM, SSD_STATE
    o1 = CONV_CH
    o2 = 2 * CONV_CH
    o3 = o2 + SSD_INNER
    o4 = o3 + SSD_CONV_DIM
    c_val, c_gate, z, xbc, dt_raw = u[..., :o1], u[..., o1:o2], u[..., o2:o3], u[..., o3:o4], u[..., o4:]

    a = c_val * jax.nn.sigmoid(c_gate)
    a_pad = jnp.concatenate([conv_buf.astype(a.dtype), a], axis=1)
    new_conv_buf = a_pad[:, -(CONV_WIDTH - 1):]
    c = jax.nn.silu(layer_norm(causal_dwconv(a_pad, conv_dw_w, conv_dw_b), conv_ln_g, conv_ln_b))

    xbc_pad = jnp.concatenate([xbc_buf.astype(xbc.dtype), xbc], axis=1)
    new_xbc_buf = xbc_pad[:, -(SSD_CONV_WIDTH - 1):]
    xbc = jax.nn.silu(causal_dwconv(xbc_pad, ssd_conv_w, ssd_conv_b))
    xs = xbc[..., :SSD_INNER]
    Bm = xbc[..., SSD_INNER:SSD_INNER + G * N].astype(f32).reshape(b, T, G, N)
    Cm = xbc[..., SSD_INNER + G * N:].astype(f32).reshape(b, T, G, N)
    dt = jax.nn.softplus(dt_raw.astype(f32) + ssd_dt_bias.astype(f32)).reshape(b, T, G, J)
    A = -jnp.exp(ssd_A_log.astype(f32)).reshape(G, J)
    xh = xs.astype(f32).reshape(b, T, G, J, P)
    S0 = ssm.astype(f32).reshape(b, G, J, P, N)
    y, S = ssd_scan(xh, dt, A, Bm, Cm, S0)
    y = y + ssd_D.astype(f32).reshape(G, J)[:, :, None] * xh
    y = y.reshape(b, T, SSD_INNER).astype(u.dtype)
    y = rms_norm(y * jax.nn.silu(z), ssd_norm)

    m = jnp.concatenate([c, y], axis=-1)
    return m, new_conv_buf, new_xbc_buf, S.reshape(b, SSD_HEADS, P, N).astype(u.dtype)


def trunk_layer(x, p, conv_buf, xbc_buf, ssm, w):
    (ffn1_norm, ffn1_w_gate, ffn1_w_up, ffn1_w_down, mix_norm, w_in,
     conv_dw_w, conv_dw_b, conv_ln_g, conv_ln_b, ssd_conv_w, ssd_conv_b,
     ssd_dt_bias, ssd_A_log, ssd_D, ssd_norm, w_out,
     ffn2_norm, ffn2_w_gate, ffn2_w_up, ffn2_w_down,
     ple_norm, ple_w_proj, ple_w_gate) = w
    h = x + 0.5 * swiglu_ffn(rms_norm(x, ffn1_norm), ffn1_w_gate, ffn1_w_up, ffn1_w_down)
    u = rms_norm(h, mix_norm) @ w_in
    m, nc, nx, ns = hybrid_mixer(u, conv_buf, xbc_buf, ssm, conv_dw_w, conv_dw_b, conv_ln_g, conv_ln_b,
                                 ssd_conv_w, ssd_conv_b, ssd_dt_bias, ssd_A_log, ssd_D, ssd_norm)
    h = h + m @ w_out
    h = h + 0.5 * swiglu_ffn(rms_norm(h, ffn2_norm), ffn2_w_gate, ffn2_w_up, ffn2_w_down)
    gate = jax.nn.sigmoid(rms_norm(h, ple_norm) @ ple_w_gate)
    h = h + gate * (p.astype(h.dtype) @ ple_w_proj)
    return h, nc, nx, ns


def setup_inputs(seed: int = 0) -> dict:
    key = jax.random.key(seed)
    ks = jax.random.split(key, 40)
    f32 = jnp.float32

    def nrm(k, shape, scale):
        return jax.random.normal(k, shape, f32) * scale

    def gain(k, shape):
        return 1.0 + 0.05 * jax.random.normal(k, shape, f32)

    dt0 = jnp.exp(jax.random.uniform(ks[30], (DEPTH, SSD_HEADS), f32)
                  * (np.log(0.1) - np.log(0.001)) + np.log(0.001))
    dt_bias = dt0 + jnp.log(-jnp.expm1(-dt0))
    A_log = jnp.log(jax.random.uniform(ks[31], (DEPTH, SSD_HEADS), f32, 1.0, 16.0))

    return {
        "x_prompt": nrm(ks[0], (BATCH, SEQ, D_MODEL), 1.0),
        "x_sample": nrm(ks[1], (DEC_BATCH, DEC_SEQ, D_MODEL), 1.0),
        "p_prompt": nrm(ks[2], (DEPTH, BATCH, SEQ, D_PLE), 1.0),
        "p_sample": nrm(ks[3], (DEPTH, DEC_BATCH, DEC_SEQ, D_PLE), 1.0),
        "state_conv": nrm(ks[4], (DEPTH, DEC_BATCH, CONV_WIDTH - 1, CONV_CH), 0.5),
        "state_ssd_conv": nrm(ks[5], (DEPTH, DEC_BATCH, SSD_CONV_WIDTH - 1, SSD_CONV_DIM), 0.5),
        "state_ssd": nrm(ks[6], (DEPTH, DEC_BATCH, SSD_HEADS, SSD_HEAD_DIM, SSD_STATE), 0.5),
        "ffn1_norm": gain(ks[7], (DEPTH, D_MODEL)),
        "ffn1_w_gate": nrm(ks[8], (DEPTH, D_MODEL, D_FF), D_MODEL ** -0.5),
        "ffn1_w_up": nrm(ks[9], (DEPTH, D_MODEL, D_FF), D_MODEL ** -0.5),
        "ffn1_w_down": nrm(ks[10], (DEPTH, D_FF, D_MODEL), D_FF ** -0.5),
        "mix_norm": gain(ks[11], (DEPTH, D_MODEL)),
        "w_in": nrm(ks[12], (DEPTH, D_MODEL, IN_PROJ), D_MODEL ** -0.5),
        "conv_dw_w": nrm(ks[13], (DEPTH, CONV_WIDTH, CONV_CH), CONV_WIDTH ** -0.5),
        "conv_dw_b": nrm(ks[14], (DEPTH, CONV_CH), 0.01),
        "conv_ln_g": gain(ks[15], (DEPTH, CONV_CH)),
        "conv_ln_b": nrm(ks[16], (DEPTH, CONV_CH), 0.01),
        "ssd_conv_w": nrm(ks[17], (DEPTH, SSD_CONV_WIDTH, SSD_CONV_DIM), SSD_CONV_WIDTH ** -0.5),
        "ssd_conv_b": nrm(ks[18], (DEPTH, SSD_CONV_DIM), 0.01),
        "ssd_dt_bias": dt_bias,
        "ssd_A_log": A_log,
        "ssd_D": gain(ks[19], (DEPTH, SSD_HEADS)),
        "ssd_norm": gain(ks[20], (DEPTH, SSD_INNER)),
        "w_out": nrm(ks[21], (DEPTH, MIX_WIDTH, D_MODEL), MIX_WIDTH ** -0.5),
        "ffn2_norm": gain(ks[22], (DEPTH, D_MODEL)),
        "ffn2_w_gate": nrm(ks[23], (DEPTH, D_MODEL, D_FF), D_MODEL ** -0.5),
        "ffn2_w_up": nrm(ks[24], (DEPTH, D_MODEL, D_FF), D_MODEL ** -0.5),
        "ffn2_w_down": nrm(ks[25], (DEPTH, D_FF, D_MODEL), D_FF ** -0.5),
        "ple_norm": gain(ks[26], (DEPTH, D_MODEL)),
        "ple_w_proj": nrm(ks[27], (DEPTH, D_PLE, D_MODEL), D_PLE ** -0.5),
        "ple_w_gate": nrm(ks[28], (DEPTH, D_MODEL, D_MODEL), D_MODEL ** -0.5),
        "final_norm": gain(ks[29], (D_MODEL,)),
    }


def reference(x_prompt, x_sample, p_prompt, p_sample, state_conv, state_ssd_conv, state_ssd,
              ffn1_norm, ffn1_w_gate, ffn1_w_up, ffn1_w_down, mix_norm, w_in,
              conv_dw_w, conv_dw_b, conv_ln_g, conv_ln_b, ssd_conv_w, ssd_conv_b,
              ssd_dt_bias, ssd_A_log, ssd_D, ssd_norm, w_out,
              ffn2_norm, ffn2_w_gate, ffn2_w_up, ffn2_w_down,
              ple_norm, ple_w_proj, ple_w_gate, final_norm):
    bp = x_prompt.shape[0]
    h_p, h_s = x_prompt, x_sample
    conv_p, xbc_p, ssm_p, conv_s, xbc_s, ssm_s = [], [], [], [], [], []
    for i in range(DEPTH):
        w_i = (ffn1_norm[i], ffn1_w_gate[i], ffn1_w_up[i], ffn1_w_down[i], mix_norm[i], w_in[i],
               conv_dw_w[i], conv_dw_b[i], conv_ln_g[i], conv_ln_b[i], ssd_conv_w[i], ssd_conv_b[i],
               ssd_dt_bias[i], ssd_A_log[i], ssd_D[i], ssd_norm[i], w_out[i],
               ffn2_norm[i], ffn2_w_gate[i], ffn2_w_up[i], ffn2_w_down[i],
               ple_norm[i], ple_w_proj[i], ple_w_gate[i])
        zc = jnp.zeros((bp, CONV_WIDTH - 1, CONV_CH), x_prompt.dtype)
        zx = jnp.zeros((bp, SSD_CONV_WIDTH - 1, SSD_CONV_DIM), x_prompt.dtype)
        zs = jnp.zeros((bp, SSD_HEADS, SSD_HEAD_DIM, SSD_STATE), x_prompt.dtype)
        h_p, c1, x1, s1 = trunk_layer(h_p, p_prompt[i], zc, zx, zs, w_i)
        h_s, c2, x2, s2 = trunk_layer(h_s, p_sample[i], state_conv[i], state_ssd_conv[i], state_ssd[i], w_i)
        conv_p.append(c1); xbc_p.append(x1); ssm_p.append(s1)
        conv_s.append(c2); xbc_s.append(x2); ssm_s.append(s2)
    y_prompt = rms_norm(h_p, final_norm)
    y_sample = rms_norm(h_s, final_norm)
    return (y_prompt, y_sample,
            jnp.stack(conv_p), jnp.stack(xbc_p), jnp.stack(ssm_p),
            jnp.stack(conv_s), jnp.stack(xbc_s), jnp.stack(ssm_s))
```

```cpp
#include <hip/hip_runtime.h>
#include <hip/hip_cooperative_groups.h>
#include <cstdio>
#include <cstdint>
namespace cg = cooperative_groups;

#ifndef MK_LAUNCHES
#define MK_LAUNCHES 1
#endif

#define LAS __attribute__((address_space(3)))
typedef unsigned short bf16_t;
typedef short bf16x8 __attribute__((ext_vector_type(8)));
typedef float f32x4 __attribute__((ext_vector_type(4)));
typedef float f32x2 __attribute__((ext_vector_type(2)));
typedef float f32x16 __attribute__((ext_vector_type(16)));
typedef unsigned u32x4 __attribute__((ext_vector_type(4)));
typedef unsigned u32x2 __attribute__((ext_vector_type(2)));
typedef __bf16 bf16x2_t __attribute__((ext_vector_type(2)));

constexpr int DM = 1024, FF = 2816, NPR = 32768, NSM = 1024, MT = NPR + NSM;
constexpr int SEQ = 16384, NCH = 528, NCHP = 512;
constexpr int NIN = 4864, NINR = 4624;
constexpr float EPS = 1e-6f;
constexpr int NPH = 15;
constexpr size_t O_Y = 0, O_CP = 34603008, O_XP = 34664448, O_SP = 34673664, O_CS = 34935808, O_XS = 35427328, O_SS = 35501056, O_END = 37598208;
constexpr size_t MiB = 1u << 20;
constexpr size_t WS_CTL = 0, CTL_BYTES = 2 * MiB, WS_BAR = 1 * MiB;
constexpr size_t WS_WGU1 = 2 * MiB, WS_WD1 = 13 * MiB, WS_WIN = 18 * MiB + MiB / 2, WS_WOUT = 28 * MiB, WS_WGU2 = 32 * MiB, WS_WD2 = 43 * MiB,
                 WS_WPG = 48 * MiB + MiB / 2, WS_WPP = 50 * MiB + MiB / 2;
constexpr size_t WS_HB = 54 * MiB;
constexpr size_t WS_ACT = 120 * MiB;
constexpr size_t WS_M = 120 * MiB, WS_BN = 252 * MiB, WS_BT = 268 * MiB + MiB / 2, WS_CN = 285 * MiB;
constexpr size_t WS_XBC = 301 * MiB + MiB / 2;
constexpr size_t WS_L = WS_XBC, WS_PB = WS_XBC;
constexpr size_t WS_AC = 433 * MiB + MiB / 2;
constexpr size_t WS_PROJ = WS_AC;
constexpr size_t WS_DTR = 500 * MiB, WS_DT = 502 * MiB + MiB / 2, WS_ACU = 505 * MiB, WS_END = 508 * MiB;

__device__ __forceinline__ unsigned pk2(float lo, float hi) { f32x2 v = {lo, hi}; bf16x2_t b = __builtin_convertvector(v, bf16x2_t); return __builtin_bit_cast(unsigned, b); }
__device__ __forceinline__ float bflo(unsigned u) { return __uint_as_float(u << 16); }
__device__ __forceinline__ float bfhi(unsigned u) { return __uint_as_float(u & 0xffff0000u); }
__device__ __forceinline__ float bf1(bf16_t u) { return __uint_as_float(((unsigned)u) << 16); }
__device__ __forceinline__ bf16_t f2bf(float f) { return (bf16_t)(pk2(f, 0.f) & 0xffffu); }
__device__ __forceinline__ float sigm(float x) { return __builtin_amdgcn_rcpf(1.f + __expf(-x)); }
__device__ __forceinline__ float wave_sum(float v) {
#pragma unroll
    for (int o = 1; o < 64; o <<= 1) v += __shfl_xor(v, o);
    return v;
}
__device__ __forceinline__ int crow(int r, int hi) { return (r & 3) + 8 * (r >> 2) + 4 * hi; }
#define MFMA32(a, b, c) __builtin_amdgcn_mfma_f32_32x32x16_bf16((a), (b), (c), 0, 0, 0)

namespace pg8 {
constexpr int BM = 256, BK = 64, HALF = 128, HTB = HALF * BK * 2, STAGE_BYTES = 8 * HTB, NXCD = 8, WGM = 8;
__host__ __device__ __forceinline__ int lds_byte(int r, int c) { const int st = (r >> 4) * 2 + (c >> 5), rr = r & 15, cc = c & 31, ob = rr * 64 + cc * 2; return st * 1024 + (ob ^ (((ob >> 9) & 1) << 5)); }
__host__ __device__ __forceinline__ void stage_rc(int b, int& R, int& C) { const int st = b / 1024, sb = b % 1024, swz = sb ^ (((sb >> 9) & 1) << 5); R = (st >> 1) * 16 + swz / 64; C = (st & 1) * 32 + (swz % 64) / 2; }
__host__ __device__ __forceinline__ int perm32(int rho) { const int n = rho >> 4, i = rho & 15; return 8 * (i >> 2) + 4 * n + (i & 3); }
struct Unit { int pm, pn; };
struct Gemm { const bf16_t* A; const bf16_t* Bt; int M, N, K; int ablk; };
struct StaticOrder {
    int nM, nN, nwg, G, c, pm0, Lbase, Lend;
    __host__ __device__ void init(int M, int N, int G_, int c_, int pm0_ = 0) { nM = M / BM; nN = N / BM; nwg = nM * nN; G = G_; c = c_; pm0 = pm0_; Lbase = 0; Lend = nwg; }
    __host__ __device__ __forceinline__ int panel_of(int L) const {
        int wgid = L; { const int q = nwg / NXCD, r = nwg % NXCD, xcd = wgid % NXCD, off = wgid / NXCD; wgid = (xcd < r ? xcd * (q + 1) : r * (q + 1) + (xcd - r) * q) + off; }
        const int nig = WGM * nN, gid = wgid / nig, fm = gid * WGM, gsz = (nM - fm) < WGM ? (nM - fm) : WGM;
        return pm0 + fm + ((wgid % nig) % gsz);
    }
    __host__ __device__ bool next(int i, Unit& u) const {
        const long L = (long)Lbase + (long)i * G + c; if (L >= Lend) return false;
        int wgid = (int)L; { const int q = nwg / NXCD, r = nwg % NXCD, xcd = wgid % NXCD, off = wgid / NXCD; wgid = (xcd < r ? xcd * (q + 1) : r * (q + 1) + (xcd - r) * q) + off; }
        const int nig = WGM * nN, gid = wgid / nig, fm = gid * WGM, gsz = (nM - fm) < WGM ? (nM - fm) : WGM;
        u.pm = pm0 + fm + ((wgid % nig) % gsz); u.pn = (wgid % nig) / gsz; return true;
    }
};
template <class Epi>
__device__ __forceinline__ void gemm_phase(LAS unsigned char* lds, const Gemm g, const StaticOrder& S, const Epi& E) {
    const int tid = threadIdx.x, wid = __builtin_amdgcn_readfirstlane(tid >> 6), lane = tid & 63, wr = wid >> 2, wc = wid & 3, fr = lane & 15, fq = lane >> 4;
    int K_ = g.K; asm volatile("" : "+s"(K_)); const int K = K_, nt = K / BK;
    unsigned voffA[2], voffB[2];
#pragma unroll
    for (int i = 0; i < 2; ++i) { int R, C; stage_rc(tid * 16 + i * 8192, R, C); const int Rb = (R & ~31) + perm32(R & 31);
        voffA[i] = (unsigned)(R * (g.ablk ? BK : K) + C) * 2u; voffB[i] = (unsigned)(Rb * K + C) * 2u; }
    const size_t kstep = (size_t)(BK * 2);
    const size_t hstep = (size_t)HALF * K * 2;
    const size_t tstep = 2 * hstep;
    const size_t kstepA = g.ablk ? (size_t)BM * BK * 2 : kstep, hstepA = g.ablk ? (size_t)HALF * BK * 2 : hstep, tstepA = g.ablk ? (size_t)nt * BM * BK * 2 : tstep;
    const unsigned ldsw = (unsigned)wid * 1024u;
    const int aoff = lds_byte(wr * 64 + fr, fq * 8), boff = lds_byte(wc * 32 + fr, fq * 8);
#define PG8_SA(b, h) (((b) * 2 + (h)) * HTB)
#define PG8_SB(b, h) ((4 + (b) * 2 + (h)) * HTB)
#define PG8_STAGE(bufoff, gbase, voff) do { _Pragma("unroll") for (int _i = 0; _i < 2; ++_i) \
        __builtin_amdgcn_global_load_lds((const unsigned*)((const char*)(gbase) + (voff)[_i]), (LAS unsigned*)(lds + (bufoff) + ldsw + _i * 8192), 16, 0, 0); } while (0)
#define PG8_LDA(dst, b, h) do { _Pragma("unroll") for (int m = 0; m < 4; ++m) _Pragma("unroll") for (int k = 0; k < 2; ++k) dst[m][k] = *(const LAS bf16x8*)(lds + PG8_SA(b, h) + aoff + m * 2048 + k * 1024); } while (0)
#define PG8_LDB(dst, b, h) do { _Pragma("unroll") for (int n = 0; n < 2; ++n) _Pragma("unroll") for (int k = 0; k < 2; ++k) dst[n][k] = *(const LAS bf16x8*)(lds + PG8_SB(b, h) + boff + n * 2048 + k * 1024); } while (0)
#define PG8_MMA(ai, bj, At, Bt) do { __builtin_amdgcn_s_setprio(1); _Pragma("unroll") for (int m = 0; m < 4; ++m) _Pragma("unroll") for (int n = 0; n < 2; ++n) _Pragma("unroll") for (int k = 0; k < 2; ++k) \
        acc[ai][bj][m][n] = __builtin_amdgcn_mfma_f32_16x16x32_bf16(Bt[n][k], At[m][k], acc[ai][bj][m][n], 0, 0, 0); __builtin_amdgcn_s_setprio(0); } while (0)
#define PG8_WAIT_V(n) asm volatile("s_waitcnt vmcnt(" #n ")" ::: "memory")
#define PG8_WAIT_L(n) asm volatile("s_waitcnt lgkmcnt(" #n ")" ::: "memory")
#define PG8_BAR __builtin_amdgcn_s_barrier()
#define PG8_SCHED __builtin_amdgcn_sched_barrier(0)
    Unit cur, nxt; int ui = 0;
    if (!S.next(0, cur)) return;
    f32x4 acc[2][2][4][2];
#pragma unroll
    for (int a = 0; a < 2; ++a)
#pragma unroll
        for (int b = 0; b < 2; ++b)
#pragma unroll
            for (int m = 0; m < 4; ++m)
#pragma unroll
                for (int n = 0; n < 2; ++n) acc[a][b][m][n] = (f32x4){0.f, 0.f, 0.f, 0.f};
    bf16x8 At[4][2], B0[2][2], B1[2][2];
    const char* cA = (const char*)g.A + (size_t)cur.pm * tstepA; const char* cB = (const char*)g.Bt + (size_t)cur.pn * tstep;
    PG8_STAGE(PG8_SB(0, 0), cB, voffB); PG8_STAGE(PG8_SB(0, 1), cB + hstep, voffB); PG8_STAGE(PG8_SA(0, 0), cA, voffA); PG8_STAGE(PG8_SA(0, 1), cA + hstepA, voffA);
    if (wr == 1) PG8_BAR;
    PG8_WAIT_V(2); PG8_BAR;
    PG8_STAGE(PG8_SB(1, 0), cB + kstep, voffB); PG8_STAGE(PG8_SA(1, 0), cA + kstepA, voffA); PG8_STAGE(PG8_SB(1, 1), cB + hstep + kstep, voffB);
    PG8_WAIT_V(6); PG8_BAR;
    for (;;) {
        const bool has_next = S.next(ui + 1, nxt);
        const char* nA = has_next ? (const char*)g.A + (size_t)nxt.pm * tstepA : cA; const char* nB = has_next ? (const char*)g.Bt + (size_t)nxt.pn * tstep : cB;
        for (int t = 0; t < nt; t += 2) {
            const bool last = (t == nt - 2);
            const char* a1 = cA + (size_t)(t + 1) * kstepA;
            const char* a2 = last ? nA : cA + (size_t)(t + 2) * kstepA; const char* b2 = last ? nB : cB + (size_t)(t + 2) * kstep;
            const char* a3 = a2 + kstepA; const char* b3 = b2 + kstep;
            PG8_LDB(B0, 0, 0); PG8_LDB(B1, 0, 1); PG8_SCHED; PG8_LDA(At, 0, 0); PG8_STAGE(PG8_SA(1, 1), a1 + hstepA, voffA);
            PG8_WAIT_V(8); PG8_WAIT_L(0); PG8_BAR; PG8_MMA(0, 0, At, B0); PG8_MMA(0, 1, At, B1); PG8_BAR; PG8_SCHED;
            PG8_LDA(At, 0, 1); PG8_STAGE(PG8_SB(0, 0), b2, voffB); PG8_STAGE(PG8_SB(0, 1), b2 + hstep, voffB); PG8_STAGE(PG8_SA(0, 0), a2, voffA);
            PG8_WAIT_V(8); PG8_WAIT_L(0); PG8_BAR; PG8_MMA(1, 0, At, B0); PG8_MMA(1, 1, At, B1); PG8_BAR; PG8_SCHED;
            PG8_LDB(B0, 1, 0); PG8_LDB(B1, 1, 1); PG8_SCHED; PG8_LDA(At, 1, 0); PG8_STAGE(PG8_SA(0, 1), a2 + hstepA, voffA);
            PG8_WAIT_V(8); PG8_WAIT_L(0); PG8_BAR; PG8_MMA(0, 0, At, B0); PG8_MMA(0, 1, At, B1); PG8_BAR; PG8_SCHED;
            PG8_LDA(At, 1, 1); PG8_STAGE(PG8_SB(1, 0), b3, voffB); PG8_STAGE(PG8_SB(1, 1), b3 + hstep, voffB); PG8_STAGE(PG8_SA(1, 0), a3, voffA);
            PG8_WAIT_V(8); PG8_WAIT_L(0); PG8_BAR; PG8_MMA(1, 0, At, B0); PG8_MMA(1, 1, At, B1); PG8_BAR; PG8_SCHED;
        }
        if (wr == 0) PG8_BAR;
        E(acc, cur, wr, wc, fr, fq);
        if (!has_next) break;
#pragma unroll
        for (int a = 0; a < 2; ++a)
#pragma unroll
            for (int b = 0; b < 2; ++b)
#pragma unroll
                for (int m = 0; m < 4; ++m)
#pragma unroll
                    for (int n = 0; n < 2; ++n) acc[a][b][m][n] = (f32x4){0.f, 0.f, 0.f, 0.f};
        cur = nxt; cA = nA; cB = nB; ++ui;
        if (wr == 1) PG8_BAR;
    }
    PG8_WAIT_V(0);
    PG8_BAR;
#undef PG8_SA
#undef PG8_SB
#undef PG8_STAGE
#undef PG8_LDA
#undef PG8_LDB
#undef PG8_MMA
#undef PG8_WAIT_V
#undef PG8_WAIT_L
#undef PG8_BAR
#undef PG8_SCHED
}
}
using pg8::Unit;
typedef f32x4 Acc[2][2][4][2];

struct EpiGU {
    const float* ss; bf16_t* O;
    __device__ __forceinline__ void operator()(const Acc& acc, const Unit& u, int wr, int wc, int fr, int fq) const {
        const int row0 = u.pm * 256 + wr * 64 + fr, col0 = u.pn * 128 + wc * 32 + 8 * fq;
        float ssv[2][4];
#pragma unroll
        for (int ai = 0; ai < 2; ++ai)
#pragma unroll
            for (int m = 0; m < 4; ++m) ssv[ai][m] = ss[row0 + ai * 128 + m * 16];
        asm volatile("" ::: "memory"); __builtin_amdgcn_sched_barrier(0);
#pragma unroll
        for (int ai = 0; ai < 2; ++ai)
#pragma unroll
            for (int m = 0; m < 4; ++m) {
                const int row = row0 + ai * 128 + m * 16; const float rs = rsqrtf(ssv[ai][m] * (1.f / DM) + EPS);
                const float rs2 = -rs * 1.4426950408889634f, rsq = rs * rs;
                float o[8];
#pragma unroll
                for (int n = 0; n < 2; ++n) {
                    const f32x4 g4 = acc[ai][0][m][n], u4 = acc[ai][1][m][n]; const f32x4 t = g4 * rs2; f32x4 e;
#pragma unroll
                    for (int j = 0; j < 4; ++j) e[j] = __builtin_amdgcn_exp2f(t[j]);
                    const f32x4 d = e + 1.0f; f32x4 r;
#pragma unroll
                    for (int j = 0; j < 4; ++j) r[j] = __builtin_amdgcn_rcpf(d[j]);
                    const f32x4 v = (g4 * u4) * (r * rsq);
#pragma unroll
                    for (int j = 0; j < 4; ++j) o[4 * n + j] = v[j];
                }
                u32x4 w; w.x = pk2(o[0], o[1]); w.y = pk2(o[2], o[3]); w.z = pk2(o[4], o[5]); w.w = pk2(o[6], o[7]);
                *(u32x4*)(O + ((((size_t)(row >> 8) * (FF / 64) + (col0 >> 6)) * 256 + (row & 255)) * 64 + (col0 & 63))) = w;
            }
    }
};
template <bool BASE_F32>
struct EpiDown {
    const float* baseP; const float* baseS; bf16_t* HB; float* ssn; float alpha; const float* rsc;
    __device__ __forceinline__ void operator()(const Acc& acc, const Unit& u, int wr, int wc, int fr, int fq) const {
        const int row0 = u.pm * 256 + wr * 64 + fr, col0 = u.pn * 256 + wc * 32 + 8 * fq;
#pragma unroll
        for (int ai = 0; ai < 2; ++ai) {
            f32x4 pre[4][2][2]; float al[4];
#pragma unroll
            for (int m = 0; m < 4; ++m) {
                const int row = row0 + ai * 128 + m * 16;
                al[m] = rsc ? alpha * rsqrtf(rsc[row] * (1.f / 1024.f) + EPS) : alpha;
                if (BASE_F32) {
                    const float* bp = row < NPR ? baseP + (size_t)row * DM : baseS + (size_t)(row - NPR) * DM;
#pragma unroll
                    for (int bj = 0; bj < 2; ++bj) { pre[m][bj][0] = *(const f32x4*)(bp + col0 + bj * 128); pre[m][bj][1] = *(const f32x4*)(bp + col0 + bj * 128 + 4); }
                } else {
#pragma unroll
                    for (int bj = 0; bj < 2; ++bj) { const u32x4 r = *(const u32x4*)(HB + (size_t)row * DM + col0 + bj * 128);
                        pre[m][bj][0] = (f32x4){bflo(r.x), bfhi(r.x), bflo(r.y), bfhi(r.y)}; pre[m][bj][1] = (f32x4){bflo(r.z), bfhi(r.z), bflo(r.w), bfhi(r.w)}; }
                }
            }
#pragma unroll
            for (int m = 0; m < 4; ++m) {
                const int row = row0 + ai * 128 + m * 16;
                float q = 0.f;
#pragma unroll
                for (int bj = 0; bj < 2; ++bj) {
                    const int col = col0 + bj * 128;
                    const f32x4 v0 = pre[m][bj][0] + acc[ai][bj][m][0] * al[m], v1 = pre[m][bj][1] + acc[ai][bj][m][1] * al[m];
                    u32x4 w; w.x = pk2(v0[0], v0[1]); w.y = pk2(v0[2], v0[3]); w.z = pk2(v1[0], v1[1]); w.w = pk2(v1[2], v1[3]);
                    *(u32x4*)(HB + (size_t)row * DM + col) = w;
                    q += (v0[0] * v0[0] + v0[1] * v0[1]) + (v0[2] * v0[2] + v0[3] * v0[3]) + (v1[0] * v1[0] + v1[1] * v1[1]) + (v1[2] * v1[2] + v1[3] * v1[3]);
                }
                q += __shfl_xor(q, 16); q += __shfl_xor(q, 32);
                if (fq == 0) unsafeAtomicAdd(ssn + row, q);
            }
            asm volatile("" ::: "memory");
        }
    }
};
struct EpiIn {
    const float* ss; bf16_t* AC; bf16_t* Mz; bf16_t* XBC; float* DTR;
    __device__ __forceinline__ void operator()(const Acc& acc, const Unit& u, int wr, int wc, int fr, int fq) const {
        const int row0 = u.pm * 256 + wr * 64 + fr; const int pn = u.pn;
        float ssv[2][4];
#pragma unroll
        for (int ai = 0; ai < 2; ++ai)
#pragma unroll
            for (int m = 0; m < 4; ++m) ssv[ai][m] = ss[row0 + ai * 128 + m * 16];
        asm volatile("" ::: "memory"); __builtin_amdgcn_sched_barrier(0);
#pragma unroll
        for (int ai = 0; ai < 2; ++ai)
#pragma unroll
            for (int m = 0; m < 4; ++m) {
                const int row = row0 + ai * 128 + m * 16; const float rs = rsqrtf(ssv[ai][m] * (1.f / DM) + EPS); const float rs2 = -rs * 1.4426950408889634f;
                if (pn < 8) {
                    float o[8];
#pragma unroll
                    for (int n = 0; n < 2; ++n) {
                        const f32x4 v4 = acc[ai][0][m][n], t = acc[ai][1][m][n] * rs2; f32x4 e, r;
#pragma unroll
                        for (int j = 0; j < 4; ++j) e[j] = __builtin_amdgcn_exp2f(t[j]);
                        const f32x4 d = e + 1.0f;
#pragma unroll
                        for (int j = 0; j < 4; ++j) r[j] = __builtin_amdgcn_rcpf(d[j]);
                        const f32x4 q = v4 * (r * rs);
#pragma unroll
                        for (int j = 0; j < 4; ++j) o[4 * n + j] = q[j];
                    }
                    u32x4 w; w.x = pk2(o[0], o[1]); w.y = pk2(o[2], o[3]); w.z = pk2(o[4], o[5]); w.w = pk2(o[6], o[7]);
                    *(u32x4*)(AC + (size_t)row * 1024 + pn * 128 + wc * 32 + 8 * fq) = w;
                } else if (pn < 18) {
#pragma unroll
                    for (int bj = 0; bj < 2; ++bj) {
                        float o[8];
#pragma unroll
                        for (int n = 0; n < 2; ++n) {
                            const f32x4 a4 = acc[ai][bj][m][n]; f32x4 q;
                            if (pn < 12) {
                                const f32x4 t = a4 * rs2; f32x4 e, r;
#pragma unroll
                                for (int j = 0; j < 4; ++j) e[j] = __builtin_amdgcn_exp2f(t[j]);
                                const f32x4 d = e + 1.0f;
#pragma unroll
                                for (int j = 0; j < 4; ++j) r[j] = __builtin_amdgcn_rcpf(d[j]);
                                q = a4 * (r * rs);
                            } else q = a4 * rs;
#pragma unroll
                            for (int j = 0; j < 4; ++j) o[4 * n + j] = q[j];
                        }
                        u32x4 w; w.x = pk2(o[0], o[1]); w.y = pk2(o[2], o[3]); w.z = pk2(o[4], o[5]); w.w = pk2(o[6], o[7]);
                        const int cl = bj * 128 + wc * 32 + 8 * fq;
                        if (pn < 12) *(u32x4*)(Mz + (size_t)row * 2048 + 1024 + (pn - 8) * 256 + cl) = w;
                        else *(u32x4*)(XBC + (size_t)row * 1536 + (pn - 12) * 256 + cl) = w;
                    }
                } else {
                    if (wc == 0 && fq < 2) { *(f32x4*)(DTR + (size_t)row * 16 + 8 * fq) = acc[ai][0][m][0] * rs; *(f32x4*)(DTR + (size_t)row * 16 + 8 * fq + 4) = acc[ai][0][m][1] * rs; }
                }
            }
    }
};
struct EpiProj {
    bf16_t* O;
    __device__ __forceinline__ void operator()(const Acc& acc, const Unit& u, int wr, int wc, int fr, int fq) const {
        const int row0 = u.pm * 256 + wr * 64 + fr, col0 = u.pn * 256 + wc * 32 + 8 * fq;
#pragma unroll
        for (int ai = 0; ai < 2; ++ai)
#pragma unroll
            for (int m = 0; m < 4; ++m)
#pragma unroll
                for (int bj = 0; bj < 2; ++bj) {
                    const f32x4 v0 = acc[ai][bj][m][0], v1 = acc[ai][bj][m][1];
                    u32x4 w; w.x = pk2(v0[0], v0[1]); w.y = pk2(v0[2], v0[3]); w.z = pk2(v1[0], v1[1]); w.w = pk2(v1[2], v1[3]);
                    *(u32x4*)(O + (size_t)(row0 + ai * 128 + m * 16) * DM + col0 + bj * 128) = w;
                }
    }
};
struct EpiPle {
    const float* ss; const bf16_t* P; const bf16_t* HBr; bf16_t* H4; float* ssn; float mul;
    __device__ __forceinline__ void operator()(const Acc& acc, const Unit& u, int wr, int wc, int fr, int fq) const {
        const int row0 = u.pm * 256 + wr * 64 + fr, col0 = u.pn * 256 + wc * 32 + 8 * fq;
#pragma unroll
        for (int ai = 0; ai < 2; ++ai)
#pragma unroll
            for (int mp = 0; mp < 2; ++mp) {
                f32x4 hb[2][2][2]; u32x4 pw[2][2]; float rsv[2];
#pragma unroll
                for (int mm = 0; mm < 2; ++mm) { const int row = row0 + ai * 128 + (2 * mp + mm) * 16; rsv[mm] = rsqrtf(ss[row] * (1.f / DM) + EPS);
#pragma unroll
                    for (int bj = 0; bj < 2; ++bj) { const u32x4 r = *(const u32x4*)(HBr + (size_t)row * DM + col0 + bj * 128);
                        hb[mm][bj][0] = (f32x4){bflo(r.x), bfhi(r.x), bflo(r.y), bfhi(r.y)}; hb[mm][bj][1] = (f32x4){bflo(r.z), bfhi(r.z), bflo(r.w), bfhi(r.w)};
                        pw[mm][bj] = *(const u32x4*)(P + (size_t)row * DM + col0 + bj * 128); } }
#pragma unroll
                for (int mm = 0; mm < 2; ++mm) { const int m = 2 * mp + mm; const int row = row0 + ai * 128 + m * 16; const float rs = rsv[mm];
                    float q = 0.f;
#pragma unroll
                    for (int bj = 0; bj < 2; ++bj) {
                        const u32x4 p4 = pw[mm][bj]; const f32x4 b0 = hb[mm][bj][0], b1 = hb[mm][bj][1]; const float mu = mul;
                        f32x4 v0, v1;
                        v0[0] = b0[0] + sigm(acc[ai][bj][m][0][0] * rs) * (bflo(p4.x) * mu); v0[1] = b0[1] + sigm(acc[ai][bj][m][0][1] * rs) * (bfhi(p4.x) * mu);
                        v0[2] = b0[2] + sigm(acc[ai][bj][m][0][2] * rs) * (bflo(p4.y) * mu); v0[3] = b0[3] + sigm(acc[ai][bj][m][0][3] * rs) * (bfhi(p4.y) * mu);
                        v1[0] = b1[0] + sigm(acc[ai][bj][m][1][0] * rs) * (bflo(p4.z) * mu); v1[1] = b1[1] + sigm(acc[ai][bj][m][1][1] * rs) * (bfhi(p4.z) * mu);
                        v1[2] = b1[2] + sigm(acc[ai][bj][m][1][2] * rs) * (bflo(p4.w) * mu); v1[3] = b1[3] + sigm(acc[ai][bj][m][1][3] * rs) * (bfhi(p4.w) * mu);
                        { u32x4 w; w.x = pk2(v0[0], v0[1]); w.y = pk2(v0[2], v0[3]); w.z = pk2(v1[0], v1[1]); w.w = pk2(v1[2], v1[3]); *(u32x4*)(H4 + (size_t)row * DM + col0 + bj * 128) = w; }
                        q += (v0[0] * v0[0] + v0[1] * v0[1]) + (v0[2] * v0[2] + v0[3] * v0[3]) + (v1[0] * v1[0] + v1[1] * v1[1]) + (v1[2] * v1[2] + v1[3] * v1[3]);
                    }
                    q += __shfl_xor(q, 16); q += __shfl_xor(q, 32);
                    if (fq == 0) unsafeAtomicAdd(ssn + row, q);
                }
                asm volatile("" ::: "memory");
            }
    }
};

#define XB_TMO      128
#define XB_XCNT(j)  (256  + 64 * (j))
#define XB_XSUB(j)  (1280 + 64 * (j))
#define XB_XGEN(j)  (2304 + 64 * (j))
#define XB_TOP      3328
#define XB_TOPGEN   3392
#define XCD_BAR_WORDS 3456
#define XB_SPIN_CAP (1u << 18)

__device__ __forceinline__ unsigned xb_ld(unsigned* p)              { return __hip_atomic_load(p, __ATOMIC_RELAXED, __HIP_MEMORY_SCOPE_AGENT); }
__device__ __forceinline__ unsigned xb_add(unsigned* p, unsigned v) { return __hip_atomic_fetch_add(p, v, __ATOMIC_RELAXED, __HIP_MEMORY_SCOPE_AGENT); }
__device__ __forceinline__ unsigned xb_xcc_id() { return (unsigned)__builtin_amdgcn_s_getreg((3 << 11) | 20) & 0xFu; }
#define XB_SPIN(cond, bar) do { unsigned _sp = 0; while (cond) { __builtin_amdgcn_s_sleep(1); \
    if ((++_sp & 255u) == 0u) { if (xb_ld(&(bar)[XB_TMO])) break; if (_sp > XB_SPIN_CAP) { atomicAdd(&(bar)[XB_TMO], 1u); break; } } } } while (0)

struct XcdBarrier {
    unsigned* bar; unsigned x;
    volatile LAS unsigned* st;
};

__device__ __forceinline__ XcdBarrier xcd_barrier_post(unsigned* bar, volatile LAS unsigned* st) {
    XcdBarrier b; b.bar = bar; b.x = xb_xcc_id(); b.st = st;
    if (threadIdx.x == 0) (void)xb_add(&bar[XB_XCNT(b.x)], 1u);
    return b;
}
__device__ __forceinline__ void xcd_barrier_complete(unsigned* bar, unsigned x, unsigned& nloc, unsigned& nx) {
    const unsigned G = gridDim.x * gridDim.y * gridDim.z;
    unsigned sum, cnt, mine, sp = 0u;
    for (;;) {
        sum = 0u; cnt = 0u; mine = 0u;
#pragma unroll
        for (unsigned j = 0; j < 16; ++j) { const unsigned c = xb_ld(&bar[XB_XCNT(j)]); sum += c; cnt += (c > 0u) ? 1u : 0u; mine = (j == x) ? c : mine; }
        if (sum == G) break;
        __builtin_amdgcn_s_sleep(1);
        if ((++sp & 255u) == 0u) { if (xb_ld(&bar[XB_TMO])) break; if (sp > XB_SPIN_CAP) { atomicAdd(&bar[XB_TMO], 1u); break; } }
    }
    nloc = mine > 0u ? mine : 1u; nx = cnt > 0u ? cnt : 1u;
}

__device__ __forceinline__ void xcd_barrier(const XcdBarrier& b) {
    asm volatile("s_waitcnt vmcnt(0)" ::: "memory");
    __syncthreads();
    if (threadIdx.x == 0) {
        unsigned* bar = b.bar;
        __builtin_amdgcn_s_waitcnt(0);
        unsigned nloc = b.st[0], nx = b.st[1];
        if (nloc == 0u) { xcd_barrier_complete(bar, b.x, nloc, nx); b.st[0] = nloc; b.st[1] = nx; }
        const unsigned old = xb_add(&bar[XB_XSUB(b.x)], 1u);
        const unsigned gen = old / nloc;
        if (old + 1u == (gen + 1u) * nloc) {
            __builtin_amdgcn_fence(__ATOMIC_RELEASE, "agent");
            asm volatile("s_waitcnt vmcnt(0)" ::: "memory");
            const unsigned og = xb_add(&bar[XB_TOP], 1u);
            const unsigned tg = og / nx;
            if (og + 1u == (tg + 1u) * nx) xb_add(&bar[XB_TOPGEN], 1u);
            else XB_SPIN(xb_ld(&bar[XB_TOPGEN]) == tg, bar);
            __builtin_amdgcn_fence(__ATOMIC_ACQUIRE, "agent");
            xb_add(&bar[XB_XGEN(b.x)], 1u);
            asm volatile("s_waitcnt vmcnt(0)" ::: "memory");
        } else {
            XB_SPIN(xb_ld(&bar[XB_XGEN(b.x)]) == gen, bar);
            __builtin_amdgcn_fence(__ATOMIC_ACQUIRE, "agent");
            asm volatile("s_waitcnt vmcnt(0)" ::: "memory");
        }
    }
    __syncthreads();
}

struct Args { const float* in[32]; float* out; unsigned char* ws; int ph_lo, ph_hi; };
struct Frame {
    unsigned char* lds; int tid, lane, wave, gw, ngw;
    const float* const* in; float* out; unsigned char* ws;
};
__device__ __forceinline__ size_t xt_off(int row0, int c) { return (size_t)(row0 + (c >> 4)) * 2048 + (size_t)(c & 15) * 64; }
__device__ __forceinline__ int chunk_row0(int ch) { return ch < NCHP ? ch * 64 : NPR + (ch - NCHP) * 64; }

__device__ __forceinline__ void tr_item(const float* __restrict__ W, int K, int N, const float* __restrict__ gain, bf16_t* WT, int drow0, int k0, int n0, float* scr, int lane) {
    float v[32], gv[32];
#pragma unroll
    for (int i = 0; i < 32; ++i) { const int kk = 2 * i + (lane >> 5); v[i] = W[(size_t)(k0 + kk) * N + n0 + (lane & 31)]; gv[i] = gain ? gain[k0 + kk] : 1.f; }
    asm volatile("" ::: "memory"); __builtin_amdgcn_sched_barrier(0);
#pragma unroll
    for (int i = 0; i < 32; ++i) { const int kk = 2 * i + (lane >> 5); scr[kk * 33 + (lane & 31)] = v[i] * gv[i]; }
    asm volatile("s_waitcnt lgkmcnt(0)" ::: "memory");
    const int c = lane & 7;
#pragma unroll
    for (int j = 0; j < 4; ++j) { const int n = (lane >> 3) + 8 * j; const float* s = scr + (8 * c) * 33 + n;
        u32x4 o; o.x = pk2(s[0 * 33], s[1 * 33]); o.y = pk2(s[2 * 33], s[3 * 33]); o.z = pk2(s[4 * 33], s[5 * 33]); o.w = pk2(s[6 * 33], s[7 * 33]);
        *(u32x4*)(WT + (size_t)(drow0 + n) * K + k0 + 8 * c) = o; }
    asm volatile("s_waitcnt lgkmcnt(0)" ::: "memory");
}
__device__ __forceinline__ int dest_gu(int n0, int up) { return 256 * (n0 >> 7) + (n0 & 127) + (up ? 128 : 0); }
__device__ __forceinline__ int dest_in(int n0) { if (n0 < 1024) return 256 * (n0 >> 7) + (n0 & 127); if (n0 < 2048) { const int q = n0 - 1024; return 256 * (q >> 7) + 128 + (q & 127); } return n0; }
__device__ __forceinline__ void tr_matrix_item(const float* W, int K, int N, int NB, const float* gain, bf16_t* WT, int mode, int item, float* scr, int lane) {
    const int kb = item / NB, nb = item % NB, k0 = 64 * kb, n0 = 32 * nb;
    const int d = mode == 0 ? n0 : (mode == 1 ? dest_gu(n0, 0) : (mode == 2 ? dest_gu(n0, 1) : dest_in(n0)));
    tr_item(W, K, N, gain, WT, d, k0, n0, scr, lane);
}
constexpr int I_G = 16 * 88, I_D = 44 * 32, I_IN = 16 * 144, I_O = 32 * 32, I_PG = 16 * 32, I_PP = 4 * 32;
constexpr int NITEMS = 6 * I_G + I_IN + I_O + I_PG + I_PP;
static_assert(I_G == I_D, "");
__device__ __forceinline__ void p0_range(const Frame& F, int it_lo, int it_hi, int vw, int nvw) {
    float* scr = (float*)(F.lds + F.wave * 16384);
    bf16_t* Wgu1 = (bf16_t*)(F.ws + WS_WGU1); bf16_t* Wd1 = (bf16_t*)(F.ws + WS_WD1); bf16_t* Win = (bf16_t*)(F.ws + WS_WIN); bf16_t* Wout = (bf16_t*)(F.ws + WS_WOUT);
    bf16_t* Wgu2 = (bf16_t*)(F.ws + WS_WGU2); bf16_t* Wd2 = (bf16_t*)(F.ws + WS_WD2); bf16_t* Wpg = (bf16_t*)(F.ws + WS_WPG); bf16_t* Wpp = (bf16_t*)(F.ws + WS_WPP);
    for (int it = it_lo + vw; it < it_hi; it += nvw) {
        int r = it;
        if (r < I_G) { tr_matrix_item(F.in[8], DM, FF, 88, F.in[7], Wgu1, 1, r, scr, F.lane); continue; } r -= I_G;
        if (r < I_G) { tr_matrix_item(F.in[9], DM, FF, 88, F.in[7], Wgu1, 2, r, scr, F.lane); continue; } r -= I_G;
        if (r < I_D) { tr_matrix_item(F.in[10], FF, DM, 32, nullptr, Wd1, 0, r, scr, F.lane); continue; } r -= I_D;
        if (r < I_G) { tr_matrix_item(F.in[25], DM, FF, 88, F.in[24], Wgu2, 1, r, scr, F.lane); continue; } r -= I_G;
        if (r < I_G) { tr_matrix_item(F.in[26], DM, FF, 88, F.in[24], Wgu2, 2, r, scr, F.lane); continue; } r -= I_G;
        if (r < I_D) { tr_matrix_item(F.in[27], FF, DM, 32, nullptr, Wd2, 0, r, scr, F.lane); continue; } r -= I_D;
        if (r < I_IN) { tr_matrix_item(F.in[12], DM, NINR, 144, F.in[11], Win, 3, r, scr, F.lane); continue; } r -= I_IN;
        if (r < I_O) { tr_matrix_item(F.in[23], 2048, DM, 32, (r / 32) >= 16 ? F.in[22] - 1024 : nullptr, Wout, 0, r, scr, F.lane); continue; } r -= I_O;
        if (r < I_PG) { tr_matrix_item(F.in[30], DM, DM, 32, F.in[28], Wpg, 0, r, scr, F.lane); continue; } r -= I_PG;
        tr_matrix_item(F.in[29], 256, DM, 32, nullptr, Wpp, 0, r, scr, F.lane);
    }
}
__device__ __forceinline__ void p0_dtcols(const Frame& F, int vw, int nvw) {
    bf16_t* Win = (bf16_t*)(F.ws + WS_WIN);
    for (int idx = vw * 64 + F.lane; idx < 16 * DM; idx += nvw * 64) { const int n = idx >> 10, k = idx & 1023; Win[(size_t)(4608 + n) * DM + k] = f2bf(F.in[12][(size_t)k * NINR + 4608 + n] * F.in[11][k]); }
}
__device__ __forceinline__ void p0_xb(const Frame& F) {
    bf16_t* HB = (bf16_t*)(F.ws + WS_HB); float* ss1 = (float*)(F.ws + WS_CTL);
    for (int m0 = F.gw; m0 < MT; m0 += 4 * F.ngw) {
        f32x4 v[4][4];
#pragma unroll
        for (int q = 0; q < 4; ++q) { const int m = m0 + q * F.ngw; if (m < MT) { const float* xr = m < NPR ? F.in[0] + (size_t)m * DM : F.in[1] + (size_t)(m - NPR) * DM;
#pragma unroll
            for (int j = 0; j < 4; ++j) v[q][j] = *(const f32x4*)(xr + 4 * F.lane + 256 * j); } }
#pragma unroll
        for (int q = 0; q < 4; ++q) { const int m = m0 + q * F.ngw; if (m < MT) { float s = 0.f;
#pragma unroll
            for (int j = 0; j < 4; ++j) { const f32x4 w4 = v[q][j]; s += (w4[0] * w4[0] + w4[1] * w4[1]) + (w4[2] * w4[2] + w4[3] * w4[3]);
                u32x2 w; w.x = pk2(w4[0], w4[1]); w.y = pk2(w4[2], w4[3]); *(u32x2*)(HB + (size_t)m * DM + 4 * F.lane + 256 * j) = w; }
            s = wave_sum(s); if (F.lane == 0) ss1[m] = s; } }
    }
}
__device__ __forceinline__ bool tail_idle(int nwg, int G, int c, int& e, int& ne) {
    const int R = (nwg + G - 1) / G, c0 = nwg - (R - 1) * G;
    if (c0 >= G) { e = c; ne = G; return true; }
    e = c - c0; ne = G - c0; return c >= c0;
}
__device__ __forceinline__ void cvt_pb(const Frame& F) {
    bf16_t* PB = (bf16_t*)(F.ws + WS_PB);
    for (int m0 = F.gw; m0 < MT; m0 += 4 * F.ngw) {
        f32x4 v[4];
#pragma unroll
        for (int q = 0; q < 4; ++q) { const int m = m0 + q * F.ngw; if (m < MT) v[q] = *(const f32x4*)((m < NPR ? F.in[2] + (size_t)m * 256 : F.in[3] + (size_t)(m - NPR) * 256) + 4 * F.lane); }
#pragma unroll
        for (int q = 0; q < 4; ++q) { const int m = m0 + q * F.ngw; if (m < MT) { u32x2 w; w.x = pk2(v[q][0], v[q][1]); w.y = pk2(v[q][2], v[q][3]); *(u32x2*)(PB + (size_t)m * 256 + 4 * F.lane) = w; } }
    }
}

__device__ __forceinline__ void s0_load(const Frame& F, int ch, int part, u32x4 (&raw)[11]) {
    const int row0 = chunk_row0(ch); const bool smp = ch >= NCHP; const int b = smp ? ch - NCHP : ch >> 8; const int tl0 = smp ? 0 : (ch & 255) * 64;
    const bf16_t* XBC = (const bf16_t*)(F.ws + WS_XBC);
    const int rg = F.tid & 7, c0 = (part * 64 + (F.tid >> 3)) * 8, s0 = rg * 8;
    if (tl0 > 0) {
#pragma unroll
        for (int i = 0; i < 11; ++i) raw[i] = *(const u32x4*)(XBC + (size_t)(row0 + s0 - 3 + i) * 1536 + c0);
    } else {
#pragma unroll
        for (int i = 0; i < 11; ++i) {
            const int s = s0 - 3 + i;
            if (s >= 0) raw[i] = *(const u32x4*)(XBC + (size_t)(row0 + s) * 1536 + c0);
            else if (smp) { const float* sp = F.in[5] + (size_t)(b * 3 + (s + 3)) * 1536 + c0; const f32x4 a0 = *(const f32x4*)sp, a1 = *(const f32x4*)(sp + 4);
                raw[i] = (u32x4){pk2(a0[0], a0[1]), pk2(a0[2], a0[3]), pk2(a1[0], a1[1]), pk2(a1[2], a1[3])}; }
            else raw[i] = (u32x4){0u, 0u, 0u, 0u};
        }
    }
}
__device__ __forceinline__ void s0_compute(const Frame& F, int ch, int part, const u32x4 (&raw)[11], const float (&w)[4][8], const float (&bs)[8]) {
    const int row0 = chunk_row0(ch); const bool smp = ch >= NCHP; const int b = smp ? ch - NCHP : ch >> 8;
    const bool lastc = smp || (ch & 255) == 255;
    bf16_t* XT = (bf16_t*)(F.ws + WS_M); bf16_t* Bn = (bf16_t*)(F.ws + WS_BN); bf16_t* BT = (bf16_t*)(F.ws + WS_BT); bf16_t* Cn = (bf16_t*)(F.ws + WS_CN);
    const int rg = F.tid & 7, c0 = (part * 64 + (F.tid >> 3)) * 8, s0 = rg * 8;
    if (part == 0) {
        const float* DTR = (const float*)(F.ws + WS_DTR); float* DT = (float*)(F.ws + WS_DT); float* ACU = (float*)(F.ws + WS_ACU);
        const size_t ro = (size_t)(row0 + F.lane) * 16 + 2 * F.wave;
        const f32x2 rw = *(const f32x2*)(DTR + ro), bi = *(const f32x2*)(F.in[19] + 2 * F.wave), al = *(const f32x2*)(F.in[20] + 2 * F.wave);
        f32x2 dv, av;
#pragma unroll
        for (int j = 0; j < 2; ++j) { const float x = rw[j] + bi[j]; const float e = __expf(x); const float d = x > 20.f ? x : (e < 1e-3f ? e * (1.f - 0.5f * e + 0.33333333f * e * e) : __logf(1.f + e)); dv[j] = d; float a = -__expf(al[j]) * d;
#pragma unroll
            for (int o = 1; o < 64; o <<= 1) { const float t = __shfl_up(a, o); if (F.lane >= o) a += t; }
            av[j] = a; }
        *(f32x2*)(DT + ro) = dv; *(f32x2*)(ACU + ro) = av;
    }
    float x[4][8];
#pragma unroll
    for (int i = 0; i < 3; ++i) { const u32x4 r = raw[i]; x[i][0] = bflo(r.x); x[i][1] = bfhi(r.x); x[i][2] = bflo(r.y); x[i][3] = bfhi(r.y); x[i][4] = bflo(r.z); x[i][5] = bfhi(r.z); x[i][6] = bflo(r.w); x[i][7] = bfhi(r.w); }
    unsigned tp[8][4];
    bf16_t* nat = c0 < 1280 ? Bn + (c0 - 1024) : Cn + (c0 - 1280);
#pragma unroll
    for (int q = 0; q < 4; ++q) {
        float y[2][8];
#pragma unroll
        for (int e = 0; e < 2; ++e) {
            const int i = 2 * q + e; const u32x4 r = raw[i + 3];
            float xn[8]; xn[0] = bflo(r.x); xn[1] = bfhi(r.x); xn[2] = bflo(r.y); xn[3] = bfhi(r.y); xn[4] = bflo(r.z); xn[5] = bfhi(r.z); xn[6] = bflo(r.w); xn[7] = bfhi(r.w);
#pragma unroll
            for (int j = 0; j < 8; ++j) { const float v = bs[j] + w[0][j] * x[0][j] + w[1][j] * x[1][j] + w[2][j] * x[2][j] + w[3][j] * xn[j]; y[e][j] = v * sigm(v); x[0][j] = x[1][j]; x[1][j] = x[2][j]; x[2][j] = xn[j]; }
            if (part == 2) { u32x4 o; o.x = pk2(y[e][0], y[e][1]); o.y = pk2(y[e][2], y[e][3]); o.z = pk2(y[e][4], y[e][5]); o.w = pk2(y[e][6], y[e][7]); *(u32x4*)(nat + (size_t)(row0 + s0 + i) * 256) = o; }
        }
#pragma unroll
        for (int j = 0; j < 8; ++j) tp[j][q] = pk2(y[0][j], y[1][j]);
    }
    if (c0 < 1280) {
        bf16_t* dst = c0 < 1024 ? XT + xt_off(row0, c0) + s0 : BT + ((size_t)ch * 256 + (c0 - 1024)) * 64 + s0;
#pragma unroll
        for (int j = 0; j < 8; ++j) *(u32x4*)(dst + (size_t)j * 64) = (u32x4){tp[j][0], tp[j][1], tp[j][2], tp[j][3]};
    }
    if (lastc && rg == 7) {
        float* o = F.out + (smp ? O_XS : O_XP) + (size_t)b * 3 * 1536 + c0;
#pragma unroll
        for (int i = 0; i < 3; ++i) { const u32x4 r = raw[8 + i]; *(f32x4*)(o + (size_t)i * 1536) = (f32x4){bflo(r.x), bfhi(r.x), bflo(r.y), bfhi(r.y)}; *(f32x4*)(o + (size_t)i * 1536 + 4) = (f32x4){bflo(r.z), bfhi(r.z), bflo(r.w), bfhi(r.w)}; }
    }
}
__device__ __forceinline__ void s0_phase(const Frame& F) {
    const int G = gridDim.x, bid = blockIdx.x, part = bid % 3, rank = bid / 3, nb = (G - part + 2) / 3;
    if (G < 3) { return; }
    const float* cw = F.in[17]; const float* cbias = F.in[18];
    const int c0 = (part * 64 + (F.tid >> 3)) * 8;
    float w[4][8], bs[8];
#pragma unroll
    for (int k = 0; k < 4; ++k) { const f32x4 a = *(const f32x4*)(cw + k * 1536 + c0), bq = *(const f32x4*)(cw + k * 1536 + c0 + 4);
#pragma unroll
        for (int j = 0; j < 4; ++j) { w[k][j] = a[j]; w[k][4 + j] = bq[j]; } }
    { const f32x4 a = *(const f32x4*)(cbias + c0), bq = *(const f32x4*)(cbias + c0 + 4);
#pragma unroll
      for (int j = 0; j < 4; ++j) { bs[j] = a[j]; bs[4 + j] = bq[j]; } }
    u32x4 ra[11], rb[11];
    int ch = rank;
    if (ch < NCH) s0_load(F, ch, part, ra);
    for (; ch < NCH; ch += nb) {
        const int chn = ch + nb;
        if (chn < NCH) s0_load(F, chn, part, rb);
        s0_compute(F, ch, part, ra, w, bs);
#pragma unroll
        for (int i = 0; i < 11; ++i) ra[i] = rb[i];
    }
}
__device__ __forceinline__ void cv_unit(const Frame& F, int u, const f32x2 (&ww)[31], const f32x2 bb, const f32x4 (&lg)[4], const f32x4 (&lb)[4]) {
    const int row0 = u * 16; const bool smp = row0 >= NPR; const int b = smp ? (row0 - NPR) >> 6 : row0 >> 14; const int tl0 = smp ? (row0 - NPR) & 63 : row0 & (SEQ - 1); const int T = smp ? 64 : SEQ;
    const bf16_t* AC = (const bf16_t*)(F.ws + WS_AC); bf16_t* Mo = (bf16_t*)(F.ws + WS_M); const float* ssd = (const float*)(F.ws + WS_CTL) + 5 * MT;
    const int c0 = 2 * F.tid;
    f32x2 w[46];
    if (tl0 >= 30) {
        unsigned r[46];
#pragma unroll
        for (int j = 0; j < 46; ++j) r[j] = *(const unsigned*)(AC + (size_t)(row0 - 30 + j) * 1024 + c0);
#pragma unroll
        for (int j = 0; j < 46; ++j) w[j] = (f32x2){bflo(r[j]), bfhi(r[j])};
    } else {
#pragma unroll
        for (int j = 0; j < 46; ++j) {
            const int tl = tl0 - 30 + j;
            if (tl >= 0) { const unsigned r = *(const unsigned*)(AC + (size_t)(row0 - 30 + j) * 1024 + c0); w[j] = (f32x2){bflo(r), bfhi(r)}; }
            else if (smp) { w[j] = *(const f32x2*)(F.in[4] + (size_t)(b * 30 + 30 + tl) * 1024 + c0); }
            else { w[j] = (f32x2){0.f, 0.f}; }
        }
    }
    f32x2 a[16];
#pragma unroll
    for (int t = 0; t < 16; ++t) a[t] = bb;
#pragma unroll
    for (int k = 0; k < 31; ++k) {
#pragma unroll
        for (int t = 0; t < 16; ++t) a[t] = __builtin_elementwise_fma(ww[k], w[t + k], a[t]); }
    float* L = (float*)F.lds;
#pragma unroll
    for (int t = 0; t < 16; ++t) *(f32x2*)(L + t * 1024 + c0) = a[t];
    if (tl0 + 16 > T - 30) { float* o = F.out + (smp ? O_CS : O_CP) + (size_t)b * 30 * 1024 + c0;
#pragma unroll
        for (int t = 0; t < 16; ++t) { const int q = tl0 + t - (T - 30); if (q >= 0) *(f32x2*)(o + (size_t)q * 1024) = w[30 + t]; } }
    __syncthreads();
#pragma unroll
    for (int tt = 0; tt < 2; ++tt) {
        const int t = 2 * F.wave + tt; f32x4 v[4]; float s = 0.f;
        const float inv = sqrtf(ssd[row0 + t] * (1.f / 1024.f) + EPS);
#pragma unroll
        for (int i = 0; i < 4; ++i) { v[i] = *(const f32x4*)(L + t * 1024 + 4 * F.lane + 256 * i); s += (v[i][0] + v[i][1]) + (v[i][2] + v[i][3]); }
        const float mean = wave_sum(s) * (1.f / 1024.f); float q = 0.f;
#pragma unroll
        for (int i = 0; i < 4; ++i) { v[i] = v[i] - mean; q += (v[i][0] * v[i][0] + v[i][1] * v[i][1]) + (v[i][2] * v[i][2] + v[i][3] * v[i][3]); }
        const float rstd = rsqrtf(wave_sum(q) * (1.f / 1024.f) + EPS);
#pragma unroll
        for (int i = 0; i < 4; ++i) { const int c = 4 * F.lane + 256 * i;
            float o[4];
#pragma unroll
            for (int j = 0; j < 4; ++j) { const float z = v[i][j] * rstd * lg[i][j] + lb[i][j]; o[j] = z * sigm(z) * inv; }
            u32x2 wv; wv.x = pk2(o[0], o[1]); wv.y = pk2(o[2], o[3]); *(u32x2*)(Mo + (size_t)(row0 + t) * 2048 + c) = wv; }
    }
    __syncthreads();
}
__device__ __forceinline__ void cv_phase(const Frame& F) {
    f32x2 ww[31]; f32x4 lg[4], lb[4];
    const int c0 = 2 * F.tid;
#pragma unroll
    for (int k = 0; k < 31; ++k) ww[k] = *(const f32x2*)(F.in[13] + k * 1024 + c0);
    const f32x2 bb = *(const f32x2*)(F.in[14] + c0);
#pragma unroll
    for (int i = 0; i < 4; ++i) { lg[i] = *(const f32x4*)(F.in[15] + 4 * F.lane + 256 * i); lb[i] = *(const f32x4*)(F.in[16] + 4 * F.lane + 256 * i); }
    for (int u = blockIdx.x; u < MT / 16; u += gridDim.x) cv_unit(F, u, ww, bb, lg, lb);
}
__device__ __forceinline__ void s1_unit(const Frame& F, int ub) {
    const int ch = ub >> 1, g = ub & 1, h = g * 8 + F.wave, row0 = chunk_row0(ch), l31 = F.lane & 31, hi = F.lane >> 5;
    const bf16_t* XT = (const bf16_t*)(F.ws + WS_M); const bf16_t* BT = (const bf16_t*)(F.ws + WS_BT); bf16_t* L = (bf16_t*)(F.ws + WS_L);
    const float* DT = (const float*)(F.ws + WS_DT); const float* ACU = (const float*)(F.ws + WS_ACU);
    bf16_t* Bs = (bf16_t*)F.lds;
    bf16_t* Sw = (bf16_t*)(F.lds + 20480 + F.wave * 8192);
    const int prow = F.lane >> 3, pq = F.lane & 7;
    const float ac = ACU[(size_t)(row0 + F.lane) * 16 + h], dv = DT[(size_t)(row0 + F.lane) * 16 + h];
    u32x4 bt[2], xt[8];
#pragma unroll
    for (int i = 0; i < 2; ++i) { const int p = F.tid + 512 * i; bt[i] = *(const u32x4*)(BT + ((size_t)ch * 256 + g * 128 + (p >> 3)) * 64 + (p & 7) * 8); }
#pragma unroll
    for (int i = 0; i < 8; ++i) xt[i] = *(const u32x4*)(XT + xt_off(row0, h * 64 + 8 * i + prow) + pq * 8);
#pragma unroll
    for (int i = 0; i < 2; ++i) { const int p = F.tid + 512 * i; *(u32x4*)(Bs + (p >> 3) * 72 + (p & 7) * 8) = bt[i]; }
#pragma unroll
    for (int i = 0; i < 8; ++i) { const int r = 8 * i + prow; *(u32x4*)(Sw + r * 64 + ((pq ^ (r & 7)) * 8)) = xt[i]; }
    const float we = __expf(__shfl(ac, 63) - ac) * dv;
    __syncthreads();
    f32x16 acc[2][4];
#pragma unroll
    for (int i = 0; i < 2; ++i)
#pragma unroll
        for (int j = 0; j < 4; ++j)
#pragma unroll
            for (int r = 0; r < 16; ++r) acc[i][j][r] = 0.f;
#pragma unroll
    for (int ks = 0; ks < 4; ++ks) {
        const int c = 2 * ks + hi;
        u32x4 xr[2]; bf16x8 bfr[4];
#pragma unroll
        for (int it = 0; it < 2; ++it) xr[it] = *(const u32x4*)(Sw + (32 * it + l31) * 64 + ((c ^ (l31 & 7)) * 8));
#pragma unroll
        for (int jt = 0; jt < 4; ++jt) bfr[jt] = *(const bf16x8*)(Bs + (32 * jt + l31) * 72 + 16 * ks + 8 * hi);
        float sc[8];
#pragma unroll
        for (int j = 0; j < 8; ++j) sc[j] = __shfl(we, 16 * ks + 8 * hi + j);
        bf16x8 af[2];
#pragma unroll
        for (int it = 0; it < 2; ++it) { const u32x4 r = xr[it];
            u32x4 o; o.x = pk2(bflo(r.x) * sc[0], bfhi(r.x) * sc[1]); o.y = pk2(bflo(r.y) * sc[2], bfhi(r.y) * sc[3]); o.z = pk2(bflo(r.z) * sc[4], bfhi(r.z) * sc[5]); o.w = pk2(bflo(r.w) * sc[6], bfhi(r.w) * sc[7]);
            af[it] = __builtin_bit_cast(bf16x8, o); }
#pragma unroll
        for (int it = 0; it < 2; ++it)
#pragma unroll
            for (int jt = 0; jt < 4; ++jt) acc[it][jt] = MFMA32(af[it], bfr[jt], acc[it][jt]);
        asm volatile("" ::: "memory");
    }
    __syncthreads();
    bf16_t* T = (bf16_t*)(F.lds + F.wave * 16384);
#pragma unroll
    for (int it = 0; it < 2; ++it)
#pragma unroll
        for (int jt = 0; jt < 4; ++jt)
#pragma unroll
            for (int r = 0; r < 16; ++r) T[(32 * it + crow(r, hi)) * 128 + 32 * jt + l31] = f2bf(acc[it][jt][r]);
    asm volatile("s_waitcnt lgkmcnt(0)" ::: "memory");
    bf16_t* Lo = L + ((size_t)ch * 16 + h) * 8192;
#pragma unroll
    for (int i = 0; i < 16; ++i) *(u32x4*)(Lo + (size_t)i * 512 + F.lane * 8) = *(const u32x4*)(T + i * 512 + F.lane * 8);
    asm volatile("s_waitcnt lgkmcnt(0)" ::: "memory");
    __syncthreads();
}
template <bool DRY> __device__ __forceinline__ void s2_phase(const Frame& F) {
    unsigned* Lw = (unsigned*)(F.ws + WS_L); const float* ACU = (const float*)(F.ws + WS_ACU);
    const int gt = blockIdx.x * 512 + F.tid, nt = gridDim.x * 512;
    for (int i = gt; i < 2 * 65536; i += nt) {
        const int b = i >> 16, q = i & 65535, h = q >> 12;
        float S0 = 0.f, S1 = 0.f;
        for (int c0 = 0; c0 < 256; c0 += 32) {
            unsigned lv[32]; float d[32];
#pragma unroll
            for (int k = 0; k < 32; ++k) { lv[k] = Lw[(size_t)(b * 256 + c0 + k) * 65536 + q]; d[k] = __expf(ACU[(size_t)(b * SEQ + (c0 + k) * 64 + 63) * 16 + h]); }
#pragma unroll
            for (int k = 0; k < 32; ++k) { Lw[(size_t)(b * 256 + c0 + k) * 65536 + q] = DRY ? lv[k] : pk2(S0, S1); S0 = S0 * d[k] + bflo(lv[k]); S1 = S1 * d[k] + bfhi(lv[k]); }
        }
        if (!DRY || S0 == 1.2345f) *(f32x2*)(F.out + O_SP + (size_t)b * 131072 + 2 * q) = (f32x2){S0, S1};
    }
    for (int i = gt; i < 16 * 65536; i += nt) {
        const int b = i >> 16, q = i & 65535, h = q >> 12;
        const f32x2 st = *(const f32x2*)(F.in[6] + (size_t)b * 131072 + 2 * q);
        const float d = __expf(ACU[(size_t)(NPR + b * 64 + 63) * 16 + h]);
        const unsigned lv = Lw[(size_t)(NCHP + b) * 65536 + q];
        Lw[(size_t)(NCHP + b) * 65536 + q] = DRY ? lv : pk2(st.x, st.y);
        if (!DRY || d == 1.2345f) *(f32x2*)(F.out + O_SS + (size_t)b * 131072 + 2 * q) = (f32x2){st.x * d + bflo(lv), st.y * d + bfhi(lv)};
    }
}
#define S3_TILE(CBV, SI, TI) do { \
    const int t_ = 32 * (TI) + l31; const float at_ = l_a[t_]; float wv[16]; \
    _Pragma("unroll") for (int r = 0; r < 16; ++r) { const int s_ = 32 * (SI) + crow(r, hi); const float as_ = l_a[s_], ds_ = l_a[64 + s_]; \
        float v_ = CBV[r] * __expf(fminf(at_ - as_, 0.f)) * ds_; v_ = (s_ <= t_) ? v_ : 0.f; if (s_ == t_) v_ += Dh; wv[r] = v_; } \
    _Pragma("unroll") for (int k2 = 0; k2 < 2; ++k2) { \
        u32x4 fw; fw.x = pk2(wv[8 * k2], wv[8 * k2 + 1]); fw.y = pk2(wv[8 * k2 + 2], wv[8 * k2 + 3]); fw.z = pk2(wv[8 * k2 + 4], wv[8 * k2 + 5]); fw.w = pk2(wv[8 * k2 + 6], wv[8 * k2 + 7]); \
        const bf16x8 wf = __builtin_bit_cast(bf16x8, fw); \
        _Pragma("unroll") for (int pj = 0; pj < 2; ++pj) { \
            const int row_ = 32 * pj + l31, e_ = 8 * (SI) + 4 * k2 + hi;             \
            const u32x2 lo_ = *(const u32x2*)(Sw + row_ * 64 + (((e_ >> 1) ^ (row_ & 7)) * 8) + (e_ & 1) * 4); \
            const u32x2 hi_ = *(const u32x2*)(Sw + row_ * 64 + ((((e_ + 2) >> 1) ^ (row_ & 7)) * 8) + (e_ & 1) * 4); \
            const u32x4 xw = (u32x4){lo_.x, lo_.y, hi_.x, hi_.y}; \
            y[TI][pj] = MFMA32(wf, __builtin_bit_cast(bf16x8, xw), y[TI][pj]); } } } while (0)
template <bool DRY> __device__ __forceinline__ void s3_unit(const Frame& F, int ub) {
    const int ch = ub >> 1, g = ub & 1, h = g * 8 + F.wave, row0 = chunk_row0(ch), l31 = F.lane & 31, hi = F.lane >> 5;
    const bf16_t* XT = (const bf16_t*)(F.ws + WS_M); const bf16_t* Bn = (const bf16_t*)(F.ws + WS_BN); const bf16_t* Cn = (const bf16_t*)(F.ws + WS_CN);
    const bf16_t* SP = (const bf16_t*)(F.ws + WS_L); bf16_t* Mo = (bf16_t*)(F.ws + WS_M); float* ssd = (float*)(F.ws + WS_CTL) + (DRY ? 6 : 5) * MT;
    float* Yw = (float*)(F.lds + F.wave * 16384); float* l_a = (float*)(F.lds + 131072 + F.wave * 512);
    bf16_t* Bs = (bf16_t*)F.lds; bf16_t* Cs = Bs + 64 * 136;
    bf16_t* Sw = (bf16_t*)(F.lds + 36864 + F.wave * 8192);
    const bf16_t* Sh = SP + ((size_t)ch * 16 + h) * 8192;
    const int prow = F.lane >> 3, pq = F.lane & 7;
    const float la0 = ((const float*)(F.ws + WS_ACU))[(size_t)(row0 + F.lane) * 16 + h], la1 = ((const float*)(F.ws + WS_DT))[(size_t)(row0 + F.lane) * 16 + h];
    u32x4 bc[4], st[8];
#pragma unroll
    for (int i = 0; i < 4; ++i) { const int p = F.tid + 512 * i, which = p >> 10, r = (p >> 4) & 63, c8 = (p & 15) * 8; bc[i] = *(const u32x4*)((which ? Cn : Bn) + (size_t)(row0 + r) * 256 + g * 128 + c8); }
#pragma unroll
    for (int i = 0; i < 8; ++i) st[i] = *(const u32x4*)(Sh + (size_t)(8 * i + prow) * 128 + pq * 8);
    l_a[F.lane] = la0; l_a[64 + F.lane] = la1;
#pragma unroll
    for (int i = 0; i < 4; ++i) { const int p = F.tid + 512 * i, which = p >> 10, r = (p >> 4) & 63, c8 = (p & 15) * 8; *(u32x4*)((which ? Cs : Bs) + r * 136 + c8) = bc[i]; }
#pragma unroll
    for (int i = 0; i < 8; ++i) { const int r = 8 * i + prow; *(u32x4*)(Sw + r * 64 + ((pq ^ (r & 7)) * 8)) = st[i]; }
    __syncthreads();
#pragma unroll
    for (int i = 0; i < 8; ++i) st[i] = *(const u32x4*)(Sh + (size_t)(8 * i + prow) * 128 + 64 + pq * 8);
    f32x16 cb00, cb01, cb11;
#pragma unroll
    for (int r = 0; r < 16; ++r) { cb00[r] = 0.f; cb01[r] = 0.f; cb11[r] = 0.f; }
    const bf16_t* Bp = Bs + l31 * 136 + 8 * hi; const bf16_t* Cp = Cs + l31 * 136 + 8 * hi;
#pragma unroll
    for (int ks = 0; ks < 8; ++ks) {
        const bf16x8 bf0 = *(const bf16x8*)(Bp + 16 * ks), bf1 = *(const bf16x8*)(Bp + 16 * ks + 32 * 136), cf0 = *(const bf16x8*)(Cp + 16 * ks), cf1 = *(const bf16x8*)(Cp + 16 * ks + 32 * 136);
        cb00 = MFMA32(bf0, cf0, cb00); cb01 = MFMA32(bf0, cf1, cb01); cb11 = MFMA32(bf1, cf1, cb11);
        if (ks & 1) asm volatile("" ::: "memory");
    }
    f32x16 y[2][2];
#pragma unroll
    for (int a = 0; a < 2; ++a)
#pragma unroll
        for (int bq = 0; bq < 2; ++bq)
#pragma unroll
            for (int r = 0; r < 16; ++r) y[a][bq][r] = 0.f;
#pragma unroll
    for (int kh = 0; kh < 2; ++kh) {
#pragma unroll
        for (int k = 0; k < 4; ++k) {
            const int ks = 4 * kh + k, c = 2 * k + hi;
            const bf16x8 cf0 = *(const bf16x8*)(Cp + 16 * ks), cf1 = *(const bf16x8*)(Cp + 16 * ks + 32 * 136);
            const bf16x8 sf0 = *(const bf16x8*)(Sw + l31 * 64 + ((c ^ (l31 & 7)) * 8)), sf1 = *(const bf16x8*)(Sw + (32 + l31) * 64 + ((c ^ (l31 & 7)) * 8));
            y[0][0] = MFMA32(cf0, sf0, y[0][0]); y[0][1] = MFMA32(cf0, sf1, y[0][1]); y[1][0] = MFMA32(cf1, sf0, y[1][0]); y[1][1] = MFMA32(cf1, sf1, y[1][1]);
            if (k & 1) asm volatile("" ::: "memory");
        }
#pragma unroll
        for (int i = 0; i < 8; ++i) { const int r = 8 * i + prow; *(u32x4*)(Sw + r * 64 + ((pq ^ (r & 7)) * 8)) = st[i]; }
        if (kh == 0) {
#pragma unroll
            for (int i = 0; i < 8; ++i) st[i] = *(const u32x4*)(XT + xt_off(row0, h * 64 + 8 * i + prow) + pq * 8);
        }
    }
#pragma unroll
    for (int ti = 0; ti < 2; ++ti)
#pragma unroll
        for (int r = 0; r < 16; ++r) { const float e = __expf(l_a[32 * ti + crow(r, hi)]); y[ti][0][r] *= e; y[ti][1][r] *= e; }
    const float Dh = F.in[21][h];
    const int p0 = 8 * (F.lane & 7);
    S3_TILE(cb00, 0, 0);
    S3_TILE(cb01, 0, 1);
    S3_TILE(cb11, 1, 1);
    __syncthreads();
    u32x4 zz[8];
#pragma unroll
    for (int it = 0; it < 8; ++it) zz[it] = *(const u32x4*)(Mo + (size_t)(row0 + it * 8 + (F.lane >> 3)) * 2048 + 1024 + h * 64 + p0);
#pragma unroll
    for (int ti = 0; ti < 2; ++ti)
#pragma unroll
        for (int pj = 0; pj < 2; ++pj)
#pragma unroll
            for (int r = 0; r < 16; ++r) Yw[(32 * ti + crow(r, hi)) * 64 + 32 * pj + l31] = y[ti][pj][r];
    asm volatile("s_waitcnt lgkmcnt(0)" ::: "memory");
#pragma unroll
    for (int it = 0; it < 8; ++it) {
        const int t = it * 8 + (F.lane >> 3);
        const f32x4 ya = *(const f32x4*)(Yw + t * 64 + p0), yb = *(const f32x4*)(Yw + t * 64 + p0 + 4);
        bf16_t* mp = Mo + (size_t)(row0 + t) * 2048 + 1024 + h * 64 + p0;
        const u32x4 z = zz[it];
        u32x4 o; o.x = pk2(ya[0] * bflo(z.x), ya[1] * bfhi(z.x)); o.y = pk2(ya[2] * bflo(z.y), ya[3] * bfhi(z.y)); o.z = pk2(yb[0] * bflo(z.z), yb[1] * bfhi(z.z)); o.w = pk2(yb[2] * bflo(z.w), yb[3] * bfhi(z.w));
        *(u32x4*)mp = DRY ? z : o;
        float q = (bflo(o.x) * bflo(o.x) + bfhi(o.x) * bfhi(o.x)) + (bflo(o.y) * bflo(o.y) + bfhi(o.y) * bfhi(o.y)) + (bflo(o.z) * bflo(o.z) + bfhi(o.z) * bfhi(o.z)) + (bflo(o.w) * bflo(o.w) + bfhi(o.w) * bfhi(o.w));
        q += __shfl_xor(q, 1); q += __shfl_xor(q, 2); q += __shfl_xor(q, 4);
        if ((F.lane & 7) == 0) unsafeAtomicAdd(ssd + row0 + t, q);
    }
    asm volatile("s_waitcnt lgkmcnt(0)" ::: "memory");
    __syncthreads();
}
template <bool DRY> __device__ __forceinline__ void final_phase(const Frame& F, int row_lo, int row_hi, int vw, int nvw, int mode = 0, unsigned long long mk0 = 0ull, unsigned long long mk1 = 0ull) {
#define FSEL(m) (mode == 0 || ((m) >= NPR ? mode == 2 : ((((((m) >> 8) < 64 ? mk0 >> ((m) >> 8) : mk1 >> (((m) >> 8) - 64)) & 1ull) != 0ull) == (mode == 2))))
    const float* ss5 = (const float*)(F.ws + WS_CTL) + 4 * MT; const bf16_t* H4 = (const bf16_t*)(F.ws + WS_ACT);
    f32x4 g[2][2];
#pragma unroll
    for (int j = 0; j < 2; ++j) { g[j][0] = *(const f32x4*)(F.in[31] + 8 * F.lane + 512 * j); g[j][1] = *(const f32x4*)(F.in[31] + 8 * F.lane + 512 * j + 4); }
    for (int m0 = row_lo + vw; m0 < row_hi; m0 += 4 * nvw) {
        u32x4 r[4][2]; float rs[4];
#pragma unroll
        for (int q = 0; q < 4; ++q) { const int m = m0 + q * nvw; if (m < row_hi && FSEL(m)) { rs[q] = ss5[m]; r[q][0] = *(const u32x4*)(H4 + (size_t)m * DM + 8 * F.lane); r[q][1] = *(const u32x4*)(H4 + (size_t)m * DM + 8 * F.lane + 512); } }
#pragma unroll
        for (int q = 0; q < 4; ++q) { const int m = m0 + q * nvw; if (m < row_hi && FSEL(m)) { const float sc = rsqrtf(rs[q] * (1.f / DM) + EPS); float* yp = F.out + (size_t)m * DM;
#pragma unroll
            for (int j = 0; j < 2; ++j) { const int c = 8 * F.lane + 512 * j; const u32x4 t = r[q][j];
                *(f32x4*)(yp + c) = (f32x4){bflo(t.x) * sc * g[j][0][0], bfhi(t.x) * sc * g[j][0][1], bflo(t.y) * sc * g[j][0][2], bfhi(t.y) * sc * g[j][0][3]};
                *(f32x4*)(yp + c + 4) = (f32x4){bflo(t.z) * sc * g[j][1][0], bfhi(t.z) * sc * g[j][1][1], bflo(t.w) * sc * g[j][1][2], bfhi(t.w) * sc * g[j][1][3]}; } } }
    }
}
#undef FSEL

constexpr int LDS_BYTES = 147456;
__global__ void __launch_bounds__(512, 2) fwd_kernel(Args args) {
    extern __shared__ __attribute__((aligned(16))) unsigned char lds[];
    Frame F; F.lds = lds; F.tid = threadIdx.x; F.lane = F.tid & 63; F.wave = __builtin_amdgcn_readfirstlane(F.tid >> 6);
    F.gw = blockIdx.x * 8 + F.wave; F.ngw = gridDim.x * 8; F.in = args.in; F.out = args.out; F.ws = args.ws;
    const int lo = args.ph_lo, hi = args.ph_hi, G = gridDim.x, bid = blockIdx.x;
    volatile LAS unsigned* xb_st = (volatile LAS unsigned*)((LAS unsigned char*)lds + 143360);
    if (threadIdx.x < 4) xb_st[threadIdx.x] = 0u;
    __syncthreads();
    XcdBarrier xbar; xbar.bar = (unsigned*)(args.ws + WS_BAR); xbar.x = 0; xbar.st = nullptr;
    if (hi - lo > 1) xbar = xcd_barrier_post((unsigned*)(args.ws + WS_BAR), xb_st);
    LAS unsigned char* lds3 = (LAS unsigned char*)lds;
    unsigned char* ws = args.ws;
    float* SS = (float*)(ws + WS_CTL);
    bf16_t* HB = (bf16_t*)(ws + WS_HB); bf16_t* ACT = (bf16_t*)(ws + WS_ACT); float* H = args.out;
#ifdef ONLY_PHASE
#define IN(k) ((k) == ONLY_PHASE && lo <= (k) && (k) < hi)
#else
#define IN(k) (lo <= (k) && (k) < hi)
#endif
#define SEAM(k) do { if ((k) + 1 < hi) { if ((k) == 0) cg::this_grid().sync(); else xcd_barrier(xbar); } } while (0)
#ifndef PROBE_DUP
#define PROBE_DUP 0
#endif
#define REP(k) for (int rep_ = 0; rep_ < (((PROBE_DUP >> (k)) & 1) ? 2 : 1); ++rep_)
    if ((PROBE_DUP >> 20) & 1) { for (int i_ = 0; i_ < 20; ++i_) cg::this_grid().sync(); }
    if (IN(0)) { REP(0) { p0_range(F, 0, 2 * I_G, F.gw, F.ngw); p0_xb(F); } SEAM(0);
        if (hi > 1 && F.wave == 0) {
            const unsigned c = F.lane < 16 ? xb_ld(&xbar.bar[XB_XCNT(F.lane)]) : 0u;
            unsigned sum = c;
#pragma unroll
            for (int o = 1; o < 16; o <<= 1) sum += __shfl_xor(sum, o);
            const unsigned cnt = (unsigned)__builtin_popcountll(__ballot(c > 0u)), mine = __shfl(c, (int)xbar.x);
            if (F.lane == 0 && sum == (unsigned)G && mine > 0u) { xb_st[0] = mine; xb_st[1] = cnt; }
        }
    }
    if (IN(1)) { pg8::Gemm g{HB, (const bf16_t*)(ws + WS_WGU1), MT, 2 * FF, DM, 0}; pg8::StaticOrder S; S.init(MT, 2 * FF, G, bid); EpiGU E{SS, ACT}; REP(1) pg8::gemm_phase(lds3, g, S, E);
        { int e, ne; if (tail_idle(S.nwg, G, bid, e, ne)) p0_range(F, 2 * I_G, 3 * I_G, e * 8 + F.wave, ne * 8); } SEAM(1); }
    if (IN(2)) { pg8::Gemm g{ACT, (const bf16_t*)(ws + WS_WD1), MT, DM, FF, 1}; pg8::StaticOrder S; S.init(MT, DM, G, bid); EpiDown<false> E{nullptr, nullptr, HB, SS + MT, 0.5f, nullptr}; pg8::gemm_phase(lds3, g, S, E);
        { int e, ne; if (tail_idle(S.nwg, G, bid, e, ne)) { p0_range(F, 3 * I_G, NITEMS, e * 8 + F.wave, ne * 8); p0_dtcols(F, e * 8 + F.wave, ne * 8); } } SEAM(2); }
    if (IN(3)) { pg8::Gemm g{HB, (const bf16_t*)(ws + WS_WIN), MT, NIN, DM, 0}; pg8::StaticOrder S; S.init(MT, NIN, G, bid);
        EpiIn E{SS + MT, (bf16_t*)(ws + WS_AC), (bf16_t*)(ws + WS_M), (bf16_t*)(ws + WS_XBC), (float*)(ws + WS_DTR)}; REP(3) pg8::gemm_phase(lds3, g, S, E); SEAM(3); }
    if (IN(4)) { REP(4) s0_phase(F); SEAM(4); }
    if (IN(5)) { REP(5) for (int u = bid; u < NCH * 2; u += G) s1_unit(F, u); SEAM(5); }
    if (IN(6)) { if ((PROBE_DUP >> 6) & 1) s2_phase<true>(F); s2_phase<false>(F); SEAM(6); }
    if (IN(7)) { if ((PROBE_DUP >> 7) & 1) for (int u = bid; u < NCH * 2; u += G) s3_unit<true>(F, u); for (int u = bid; u < NCH * 2; u += G) s3_unit<false>(F, u); SEAM(7); }
    if (IN(8)) { cvt_pb(F); REP(14) cv_phase(F); SEAM(8); }
    if (IN(9)) { pg8::Gemm g{(const bf16_t*)(ws + WS_M), (const bf16_t*)(ws + WS_WOUT), MT, DM, 2048, 0}; pg8::StaticOrder S; S.init(MT, DM, G, bid);
        if ((PROBE_DUP >> 9) & 1) { EpiDown<false> E0{nullptr, nullptr, HB, SS + 6 * MT, 0.0f, SS + 5 * MT}; pg8::gemm_phase(lds3, g, S, E0); }
        EpiDown<false> E{nullptr, nullptr, HB, SS + 2 * MT, 1.0f, SS + 5 * MT}; pg8::gemm_phase(lds3, g, S, E);
        { int e, ne; if (tail_idle(S.nwg, G, bid, e, ne)) { __syncthreads(); pg8::Gemm g2{(const bf16_t*)(ws + WS_PB), (const bf16_t*)(ws + WS_WPP), MT, DM, 256, 0}; pg8::StaticOrder S2; S2.init(MT, DM, ne, e); EpiProj E2{(bf16_t*)(ws + WS_PROJ)}; pg8::gemm_phase(lds3, g2, S2, E2); } }
        SEAM(9); }
    if (IN(10)) { pg8::Gemm g{HB, (const bf16_t*)(ws + WS_WGU2), MT, 2 * FF, DM, 0}; pg8::StaticOrder S; S.init(MT, 2 * FF, G, bid); EpiGU E{SS + 2 * MT, ACT}; pg8::gemm_phase(lds3, g, S, E); SEAM(10); }
    const int nsb = G >= 64 ? 16 : 1;
    int ple_full, ple_rem;
    { const int nw = (NPR / 256) * (DM / 256); ple_full = (nw / (G - nsb)) * (G - nsb); ple_rem = nw - ple_full;
      if (ple_rem > G - nsb - 8) { ple_full = nw; ple_rem = 0; } }
#define PLE_MASK(m0_, m1_) unsigned long long m0_ = 0ull, m1_ = 0ull; { pg8::StaticOrder S_; S_.init(NPR, DM, G - nsb, 0, 0); \
      for (int L_ = ple_full; L_ < S_.nwg; ++L_) { const int pm_ = S_.panel_of(L_); if (pm_ < 64) m0_ |= 1ull << pm_; else m1_ |= 1ull << (pm_ - 64); } }
    if (IN(11)) { pg8::Gemm g{ACT, (const bf16_t*)(ws + WS_WD2), MT, DM, FF, 1}; pg8::StaticOrder S; S.init(NPR, DM, G, bid, 0); EpiDown<false> E{nullptr, nullptr, HB, SS + 3 * MT, 0.5f, nullptr}; pg8::gemm_phase(lds3, g, S, E); SEAM(11); }
    if (IN(12)) {
        if (bid < nsb) { pg8::Gemm g{ACT, (const bf16_t*)(ws + WS_WD2), MT, DM, FF, 1}; pg8::StaticOrder S; S.init(NSM, DM, nsb, bid, NPR / 256); EpiDown<false> E{nullptr, nullptr, HB, SS + 3 * MT, 0.5f, nullptr}; pg8::gemm_phase(lds3, g, S, E); }
        else { pg8::Gemm g{HB, (const bf16_t*)(ws + WS_WPG), MT, DM, DM, 0}; pg8::StaticOrder S; S.init(NPR, DM, G - nsb, bid - nsb, 0); S.Lend = ple_full;
            EpiPle E{SS + 3 * MT, (const bf16_t*)(ws + WS_PROJ), HB, ACT, SS + 4 * MT, 1.f}; pg8::gemm_phase(lds3, g, S, E); }
        SEAM(12);
    }
    if (IN(13)) {
        if (bid < nsb) { pg8::Gemm g{HB, (const bf16_t*)(ws + WS_WPG), MT, DM, DM, 0}; pg8::StaticOrder S; S.init(NSM, DM, nsb, bid, NPR / 256); EpiPle E{SS + 3 * MT, (const bf16_t*)(ws + WS_PROJ), HB, ACT, SS + 4 * MT, 1.f}; pg8::gemm_phase(lds3, g, S, E); }
        else if (bid < nsb + ple_rem) { pg8::Gemm g{HB, (const bf16_t*)(ws + WS_WPG), MT, DM, DM, 0}; pg8::StaticOrder S; S.init(NPR, DM, ple_rem, bid - nsb, 0); S.Lbase = ple_full;
            EpiPle E{SS + 3 * MT, (const bf16_t*)(ws + WS_PROJ), HB, ACT, SS + 4 * MT, 1.f}; pg8::gemm_phase(lds3, g, S, E); }
        else { PLE_MASK(pmk0, pmk1); final_phase<false>(F, 0, NPR, (bid - nsb - ple_rem) * 8 + F.wave, (G - nsb - ple_rem) * 8, 1, pmk0, pmk1); }
        SEAM(13);
    }
    if (IN(14)) { PLE_MASK(pmk0, pmk1); final_phase<false>(F, 0, MT, F.gw, F.ngw, 2, pmk0, pmk1); }
#undef PLE_MASK
#undef IN
#undef SEAM
}

extern "C" void kernel_launch(void* const* d_in, const int* in_sizes, int n_in, void* d_out, int out_size, void* d_ws, size_t ws_size, hipStream_t stream) {
    static int grid = 0;
    if (grid == 0) {
        if (n_in != 32 || out_size != (int)O_END || ws_size < WS_END) { fprintf(stderr, "kernel_launch: unexpected shapes: n_in %d out %d ws %zu\n", n_in, out_size, ws_size); grid = -1; return; }
        int dev = 0, cus = 0, per_cu = 0;
        hipGetDevice(&dev); hipDeviceGetAttribute(&cus, hipDeviceAttributeMultiprocessorCount, dev);
        if (hipFuncSetAttribute((const void*)fwd_kernel, hipFuncAttributeMaxDynamicSharedMemorySize, LDS_BYTES) != hipSuccess) { fprintf(stderr, "kernel_launch: hipFuncSetAttribute failed\n"); grid = -1; return; }
        if (hipOccupancyMaxActiveBlocksPerMultiprocessor(&per_cu, (const void*)fwd_kernel, 512, LDS_BYTES) != hipSuccess || per_cu < 1) { fprintf(stderr, "kernel_launch: occupancy query failed (%d)\n", per_cu); grid = -1; (void)hipGetLastError(); return; }
        grid = cus * 1;
        fprintf(stderr, "kernel_launch: cus %d per_cu %d grid %d\n", cus, per_cu, grid);
    }
    if (grid < 0) return;
    hipMemsetAsync((char*)d_ws + WS_CTL, 0, CTL_BYTES, stream);
    Args a{};
    for (int i = 0; i < 32; ++i) a.in[i] = (const float*)d_in[i];
    a.out = (float*)d_out; a.ws = (unsigned char*)d_ws;
#if MK_LAUNCHES == 1
    a.ph_lo = 0; a.ph_hi = NPH;
    void* kargs[] = {&a};
    hipError_t e = hipLaunchCooperativeKernel((const void*)fwd_kernel, dim3(grid), dim3(512), kargs, LDS_BYTES, stream);
    if (e != hipSuccess) fprintf(stderr, "kernel_launch: cooperative launch failed: %s\n", hipGetErrorString(e));
#else
    for (int p = 0; p < NPH; ++p) { a.ph_lo = p; a.ph_hi = p + 1; hipLaunchKernelGGL(fwd_kernel, dim3(grid), dim3(512), LDS_BYTES, stream, a); }
#endif
}
```

```cpp
#include <hip/hip_runtime.h>
#include <hip/hip_cooperative_groups.h>
#include <cstdio>
#include <cstdint>
namespace cg = cooperative_groups;

#ifndef MK_LAUNCHES
#define MK_LAUNCHES 1
#endif

#define LAS __attribute__((address_space(3)))
typedef unsigned short bf16_t;
typedef short bf16x8 __attribute__((ext_vector_type(8)));
typedef float f32x4 __attribute__((ext_vector_type(4)));
typedef float f32x2 __attribute__((ext_vector_type(2)));
typedef float f32x16 __attribute__((ext_vector_type(16)));
typedef unsigned u32x4 __attribute__((ext_vector_type(4)));
typedef unsigned u32x2 __attribute__((ext_vector_type(2)));
typedef __bf16 bf16x2_t __attribute__((ext_vector_type(2)));

constexpr int DM = 1024, FF = 2816, NPR = 32768, NSM = 1024, MT = NPR + NSM;
constexpr int SEQ = 16384, NCH = 528, NCHP = 512;
constexpr int NIN = 4864, NINR = 4624;
constexpr float EPS = 1e-6f;
constexpr int NPH = 15;
constexpr size_t O_Y = 0, O_CP = 34603008, O_XP = 34664448, O_SP = 34673664, O_CS = 34935808, O_XS = 35427328, O_SS = 35501056, O_END = 37598208;
constexpr size_t MiB = 1u << 20;
constexpr size_t WS_CTL = 0, CTL_BYTES = 2 * MiB, WS_BAR = 1 * MiB;
constexpr size_t WS_WGU1 = 2 * MiB, WS_WD1 = 13 * MiB, WS_WIN = 18 * MiB + MiB / 2, WS_WOUT = 28 * MiB, WS_WGU2 = 32 * MiB, WS_WD2 = 43 * MiB,
                 WS_WPG = 48 * MiB + MiB / 2, WS_WPP = 50 * MiB + MiB / 2;
constexpr size_t WS_HB = 54 * MiB;
constexpr size_t WS_ACT = 120 * MiB;
constexpr size_t WS_M = 120 * MiB, WS_BN = 252 * MiB, WS_BT = 268 * MiB + MiB / 2, WS_CN = 285 * MiB;
constexpr size_t WS_XBC = 301 * MiB + MiB / 2;
constexpr size_t WS_L = WS_XBC, WS_PB = WS_XBC;
constexpr size_t WS_AC = 433 * MiB + MiB / 2;
constexpr size_t WS_PROJ = WS_AC;
constexpr size_t WS_DTR = 500 * MiB, WS_DT = 502 * MiB + MiB / 2, WS_ACU = 505 * MiB, WS_END = 508 * MiB;

__device__ __forceinline__ unsigned pk2(float lo, float hi) { f32x2 v = {lo, hi}; bf16x2_t b = __builtin_convertvector(v, bf16x2_t); return __builtin_bit_cast(unsigned, b); }
__device__ __forceinline__ float bflo(unsigned u) { return __uint_as_float(u << 16); }
__device__ __forceinline__ float bfhi(unsigned u) { return __uint_as_float(u & 0xffff0000u); }
__device__ __forceinline__ float bf1(bf16_t u) { return __uint_as_float(((unsigned)u) << 16); }
__device__ __forceinline__ bf16_t f2bf(float f) { return (bf16_t)(pk2(f, 0.f) & 0xffffu); }
__device__ __forceinline__ float sigm(float x) { return __builtin_amdgcn_rcpf(1.f + __expf(-x)); }
__device__ __forceinline__ float wave_sum(float v) {
#pragma unroll
    for (int o = 1; o < 64; o <<= 1) v += __shfl_xor(v, o);
    return v;
}
__device__ __forceinline__ int crow(int r, int hi) { return (r & 3) + 8 * (r >> 2) + 4 * hi; }
#define MFMA32(a, b, c) __builtin_amdgcn_mfma_f32_32x32x16_bf16((a), (b), (c), 0, 0, 0)

namespace pg8 {
constexpr int BM = 256, BK = 64, HALF = 128, HTB = HALF * BK * 2, STAGE_BYTES = 8 * HTB, NXCD = 8, WGM = 8;
__host__ __device__ __forceinline__ int lds_byte(int r, int c) { const int st = (r >> 4) * 2 + (c >> 5), rr = r & 15, cc = c & 31, ob = rr * 64 + cc * 2; return st * 1024 + (ob ^ (((ob >> 9) & 1) << 5)); }
__host__ __device__ __forceinline__ void stage_rc(int b, int& R, int& C) { const int st = b / 1024, sb = b % 1024, swz = sb ^ (((sb >> 9) & 1) << 5); R = (st >> 1) * 16 + swz / 64; C = (st & 1) * 32 + (swz % 64) / 2; }
__host__ __device__ __forceinline__ int perm32(int rho) { const int n = rho >> 4, i = rho & 15; return 8 * (i >> 2) + 4 * n + (i & 3); }
struct Unit { int pm, pn; };
struct Gemm { const bf16_t* A; const bf16_t* Bt; int M, N, K; int ablk; };
struct StaticOrder {
    int nM, nN, nwg, G, c, pm0, Lbase, Lend;
    __host__ __device__ void init(int M, int N, int G_, int c_, int pm0_ = 0) { nM = M / BM; nN = N / BM; nwg = nM * nN; G = G_; c = c_; pm0 = pm0_; Lbase = 0; Lend = nwg; }
    __host__ __device__ __forceinline__ int panel_of(int L) const {
        int wgid = L; { const int q = nwg / NXCD, r = nwg % NXCD, xcd = wgid % NXCD, off = wgid / NXCD; wgid = (xcd < r ? xcd * (q + 1) : r * (q + 1) + (xcd - r) * q) + off; }
        const int nig = WGM * nN, gid = wgid / nig, fm = gid * WGM, gsz = (nM - fm) < WGM ? (nM - fm) : WGM;
        return pm0 + fm + ((wgid % nig) % gsz);
    }
    __host__ __device__ bool next(int i, Unit& u) const {
        const long L = (long)Lbase + (long)i * G + c; if (L >= Lend) return false;
        int wgid = (int)L; { const int q = nwg / NXCD, r = nwg % NXCD, xcd = wgid % NXCD, off = wgid / NXCD; wgid = (xcd < r ? xcd * (q + 1) : r * (q + 1) + (xcd - r) * q) + off; }
        const int nig = WGM * nN, gid = wgid / nig, fm = gid * WGM, gsz = (nM - fm) < WGM ? (nM - fm) : WGM;
        u.pm = pm0 + fm + ((wgid % nig) % gsz); u.pn = (wgid % nig) / gsz; return true;
    }
};
template <class Epi>
__device__ __forceinline__ void gemm_phase(LAS unsigned char* lds, const Gemm g, const StaticOrder& S, const Epi& E) {
    const int tid = threadIdx.x, wid = __builtin_amdgcn_readfirstlane(tid >> 6), lane = tid & 63, wr = wid >> 2, wc = wid & 3, fr = lane & 15, fq = lane >> 4;
    int K_ = g.K; asm volatile("" : "+s"(K_)); const int K = K_, nt = K / BK;
    unsigned voffA[2], voffB[2];
#pragma unroll
    for (int i = 0; i < 2; ++i) { int R, C; stage_rc(tid * 16 + i * 8192, R, C); const int Rb = (R & ~31) + perm32(R & 31);
        voffA[i] = (unsigned)(R * (g.ablk ? BK : K) + C) * 2u; voffB[i] = (unsigned)(Rb * K + C) * 2u; }
    const size_t kstep = (size_t)(BK * 2);
    const size_t hstep = (size_t)HALF * K * 2;
    const size_t tstep = 2 * hstep;
    const size_t kstepA = g.ablk ? (size_t)BM * BK * 2 : kstep, hstepA = g.ablk ? (size_t)HALF * BK * 2 : hstep, tstepA = g.ablk ? (size_t)nt * BM * BK * 2 : tstep;
    const unsigned ldsw = (unsigned)wid * 1024u;
    const int aoff = lds_byte(wr * 64 + fr, fq * 8), boff = lds_byte(wc * 32 + fr, fq * 8);
#define PG8_SA(b, h) (((b) * 2 + (h)) * HTB)
#define PG8_SB(b, h) ((4 + (b) * 2 + (h)) * HTB)
#define PG8_STAGE(bufoff, gbase, voff) do { _Pragma("unroll") for (int _i = 0; _i < 2; ++_i) \
        __builtin_amdgcn_global_load_lds((const unsigned*)((const char*)(gbase) + (voff)[_i]), (LAS unsigned*)(lds + (bufoff) + ldsw + _i * 8192), 16, 0, 0); } while (0)
#define PG8_LDA(dst, b, h) do { _Pragma("unroll") for (int m = 0; m < 4; ++m) _Pragma("unroll") for (int k = 0; k < 2; ++k) dst[m][k] = *(const LAS bf16x8*)(lds + PG8_SA(b, h) + aoff + m * 2048 + k * 1024); } while (0)
#define PG8_LDB(dst, b, h) do { _Pragma("unroll") for (int n = 0; n < 2; ++n) _Pragma("unroll") for (int k = 0; k < 2; ++k) dst[n][k] = *(const LAS bf16x8*)(lds + PG8_SB(b, h) + boff + n * 2048 + k * 1024); } while (0)
#define PG8_MMA(ai, bj, At, Bt) do { __builtin_amdgcn_s_setprio(1); _Pragma("unroll") for (int m = 0; m < 4; ++m) _Pragma("unroll") for (int n = 0; n < 2; ++n) _Pragma("unroll") for (int k = 0; k < 2; ++k) \
        acc[ai][bj][m][n] = __builtin_amdgcn_mfma_f32_16x16x32_bf16(Bt[n][k], At[m][k], acc[ai][bj][m][n], 0, 0, 0); __builtin_amdgcn_s_setprio(0); } while (0)
#define PG8_WAIT_V(n) asm volatile("s_waitcnt vmcnt(" #n ")" ::: "memory")
#define PG8_WAIT_L(n) asm volatile("s_waitcnt lgkmcnt(" #n ")" ::: "memory")
#define PG8_BAR __builtin_amdgcn_s_barrier()
#define PG8_SCHED __builtin_amdgcn_sched_barrier(0)
    Unit cur, nxt; int ui = 0;
    if (!S.next(0, cur)) return;
    f32x4 acc[2][2][4][2];
#pragma unroll
    for (int a = 0; a < 2; ++a)
#pragma unroll
        for (int b = 0; b < 2; ++b)
#pragma unroll
            for (int m = 0; m < 4; ++m)
#pragma unroll
                for (int n = 0; n < 2; ++n) acc[a][b][m][n] = (f32x4){0.f, 0.f, 0.f, 0.f};
    bf16x8 At[4][2], B0[2][2], B1[2][2];
    const char* cA = (const char*)g.A + (size_t)cur.pm * tstepA; const char* cB = (const char*)g.Bt + (size_t)cur.pn * tstep;
    PG8_STAGE(PG8_SB(0, 0), cB, voffB); PG8_STAGE(PG8_SB(0, 1), cB + hstep, voffB); PG8_STAGE(PG8_SA(0, 0), cA, voffA); PG8_STAGE(PG8_SA(0, 1), cA + hstepA, voffA);
    if (wr == 1) PG8_BAR;
    PG8_WAIT_V(2); PG8_BAR;
    PG8_STAGE(PG8_SB(1, 0), cB + kstep, voffB); PG8_STAGE(PG8_SA(1, 0), cA + kstepA, voffA); PG8_STAGE(PG8_SB(1, 1), cB + hstep + kstep, voffB);
    PG8_WAIT_V(6); PG8_BAR;
    for (;;) {
        const bool has_next = S.next(ui + 1, nxt);
        const char* nA = has_next ? (const char*)g.A + (size_t)nxt.pm * tstepA : cA; const char* nB = has_next ? (const char*)g.Bt + (size_t)nxt.pn * tstep : cB;
        for (int t = 0; t < nt; t += 2) {
            const bool last = (t == nt - 2);
            const char* a1 = cA + (size_t)(t + 1) * kstepA;
            const char* a2 = last ? nA : cA + (size_t)(t + 2) * kstepA; const char* b2 = last ? nB : cB + (size_t)(t + 2) * kstep;
            const char* a3 = a2 + kstepA; const char* b3 = b2 + kstep;
            PG8_LDB(B0, 0, 0); PG8_LDB(B1, 0, 1); PG8_SCHED; PG8_LDA(At, 0, 0); PG8_STAGE(PG8_SA(1, 1), a1 + hstepA, voffA);
            PG8_WAIT_V(8); PG8_WAIT_L(0); PG8_BAR; PG8_MMA(0, 0, At, B0); PG8_MMA(0, 1, At, B1); PG8_BAR; PG8_SCHED;
            PG8_LDA(At, 0, 1); PG8_STAGE(PG8_SB(0, 0), b2, voffB); PG8_STAGE(PG8_SB(0, 1), b2 + hstep, voffB); PG8_STAGE(PG8_SA(0, 0), a2, voffA);
            PG8_WAIT_V(8); PG8_WAIT_L(0); PG8_BAR; PG8_MMA(1, 0, At, B0); PG8_MMA(1, 1, At, B1); PG8_BAR; PG8_SCHED;
            PG8_LDB(B0, 1, 0); PG8_LDB(B1, 1, 1); PG8_SCHED; PG8_LDA(At, 1, 0); PG8_STAGE(PG8_SA(0, 1), a2 + hstepA, voffA);
            PG8_WAIT_V(8); PG8_WAIT_L(0); PG8_BAR; PG8_MMA(0, 0, At, B0); PG8_MMA(0, 1, At, B1); PG8_BAR; PG8_SCHED;
            PG8_LDA(At, 1, 1); PG8_STAGE(PG8_SB(1, 0), b3, voffB); PG8_STAGE(PG8_SB(1, 1), b3 + hstep, voffB); PG8_STAGE(PG8_SA(1, 0), a3, voffA);
            PG8_WAIT_V(8); PG8_WAIT_L(0); PG8_BAR; PG8_MMA(1, 0, At, B0); PG8_MMA(1, 1, At, B1); PG8_BAR; PG8_SCHED;
        }
        if (wr == 0) PG8_BAR;
        E(acc, cur, wr, wc, fr, fq);
        if (!has_next) break;
#pragma unroll
        for (int a = 0; a < 2; ++a)
#pragma unroll
            for (int b = 0; b < 2; ++b)
#pragma unroll
                for (int m = 0; m < 4; ++m)
#pragma unroll
                    for (int n = 0; n < 2; ++n) acc[a][b][m][n] = (f32x4){0.f, 0.f, 0.f, 0.f};
        cur = nxt; cA = nA; cB = nB; ++ui;
        if (wr == 1) PG8_BAR;
    }
    PG8_WAIT_V(0);
    PG8_BAR;
#undef PG8_SA
#undef PG8_SB
#undef PG8_STAGE
#undef PG8_LDA
#undef PG8_LDB
#undef PG8_MMA
#undef PG8_WAIT_V
#undef PG8_WAIT_L
#undef PG8_BAR
#undef PG8_SCHED
}
}
using pg8::Unit;
typedef f32x4 Acc[2][2][4][2];

struct EpiGU {
    const float* ss; bf16_t* O;
    __device__ __forceinline__ void operator()(const Acc& acc, const Unit& u, int wr, int wc, int fr, int fq) const {
        const int row0 = u.pm * 256 + wr * 64 + fr, col0 = u.pn * 128 + wc * 32 + 8 * fq;
        float ssv[2][4];
#pragma unroll
        for (int ai = 0; ai < 2; ++ai)
#pragma unroll
            for (int m = 0; m < 4; ++m) ssv[ai][m] = ss[row0 + ai * 128 + m * 16];
        asm volatile("" ::: "memory"); __builtin_amdgcn_sched_barrier(0);
#pragma unroll
        for (int ai = 0; ai < 2; ++ai)
#pragma unroll
            for (int m = 0; m < 4; ++m) {
                const int row = row0 + ai * 128 + m * 16; const float rs = rsqrtf(ssv[ai][m] * (1.f / DM) + EPS);
                const float rs2 = -rs * 1.4426950408889634f, rsq = rs * rs;
                float o[8];
#pragma unroll
                for (int n = 0; n < 2; ++n) {
                    const f32x4 g4 = acc[ai][0][m][n], u4 = acc[ai][1][m][n]; const f32x4 t = g4 * rs2; f32x4 e;
#pragma unroll
                    for (int j = 0; j < 4; ++j) e[j] = __builtin_amdgcn_exp2f(t[j]);
                    const f32x4 d = e + 1.0f; f32x4 r;
#pragma unroll
                    for (int j = 0; j < 4; ++j) r[j] = __builtin_amdgcn_rcpf(d[j]);
                    const f32x4 v = (g4 * u4) * (r * rsq);
#pragma unroll
                    for (int j = 0; j < 4; ++j) o[4 * n + j] = v[j];
                }
                u32x4 w; w.x = pk2(o[0], o[1]); w.y = pk2(o[2], o[3]); w.z = pk2(o[4], o[5]); w.w = pk2(o[6], o[7]);
                *(u32x4*)(O + ((((size_t)(row >> 8) * (FF / 64) + (col0 >> 6)) * 256 + (row & 255)) * 64 + (col0 & 63))) = w;
            }
    }
};
template <bool BASE_F32>
struct EpiDown {
    const float* baseP; const float* baseS; bf16_t* HB; float* ssn; float alpha; const float* rsc;
    __device__ __forceinline__ void operator()(const Acc& acc, const Unit& u, int wr, int wc, int fr, int fq) const {
        const int row0 = u.pm * 256 + wr * 64 + fr, col0 = u.pn * 256 + wc * 32 + 8 * fq;
#pragma unroll
        for (int ai = 0; ai < 2; ++ai) {
            f32x4 pre[4][2][2]; float al[4];
#pragma unroll
            for (int m = 0; m < 4; ++m) {
                const int row = row0 + ai * 128 + m * 16;
                al[m] = rsc ? alpha * rsqrtf(rsc[row] * (1.f / 1024.f) + EPS) : alpha;
                if (BASE_F32) {
                    const float* bp = row < NPR ? baseP + (size_t)row * DM : baseS + (size_t)(row - NPR) * DM;
#pragma unroll
                    for (int bj = 0; bj < 2; ++bj) { pre[m][bj][0] = *(const f32x4*)(bp + col0 + bj * 128); pre[m][bj][1] = *(const f32x4*)(bp + col0 + bj * 128 + 4); }
                } else {
#pragma unroll
                    for (int bj = 0; bj < 2; ++bj) { const u32x4 r = *(const u32x4*)(HB + (size_t)row * DM + col0 + bj * 128);
                        pre[m][bj][0] = (f32x4){bflo(r.x), bfhi(r.x), bflo(r.y), bfhi(r.y)}; pre[m][bj][1] = (f32x4){bflo(r.z), bfhi(r.z), bflo(r.w), bfhi(r.w)}; }
                }
            }
#pragma unroll
            for (int m = 0; m < 4; ++m) {
                const int row = row0 + ai * 128 + m * 16;
                float q = 0.f;
#pragma unroll
                for (int bj = 0; bj < 2; ++bj) {
                    const int col = col0 + bj * 128;
                    const f32x4 v0 = pre[m][bj][0] + acc[ai][bj][m][0] * al[m], v1 = pre[m][bj][1] + acc[ai][bj][m][1] * al[m];
                    u32x4 w; w.x = pk2(v0[0], v0[1]); w.y = pk2(v0[2], v0[3]); w.z = pk2(v1[0], v1[1]); w.w = pk2(v1[2], v1[3]);
                    *(u32x4*)(HB + (size_t)row * DM + col) = w;
                    q += (v0[0] * v0[0] + v0[1] * v0[1]) + (v0[2] * v0[2] + v0[3] * v0[3]) + (v1[0] * v1[0] + v1[1] * v1[1]) + (v1[2] * v1[2] + v1[3] * v1[3]);
                }
                q += __shfl_xor(q, 16); q += __shfl_xor(q, 32);
                if (fq == 0) unsafeAtomicAdd(ssn + row, q);
            }
            asm volatile("" ::: "memory");
        }
    }
};
struct EpiIn {
    const float* ss; bf16_t* AC; bf16_t* Mz; bf16_t* XBC; float* DTR;
    __device__ __forceinline__ void operator()(const Acc& acc, const Unit& u, int wr, int wc, int fr, int fq) const {
        const int row0 = u.pm * 256 + wr * 64 + fr; const int pn = u.pn;
        float ssv[2][4];
#pragma unroll
        for (int ai = 0; ai < 2; ++ai)
#pragma unroll
            for (int m = 0; m < 4; ++m) ssv[ai][m] = ss[row0 + ai * 128 + m * 16];
        asm volatile("" ::: "memory"); __builtin_amdgcn_sched_barrier(0);
#pragma unroll
        for (int ai = 0; ai < 2; ++ai)
#pragma unroll
            for (int m = 0; m < 4; ++m) {
                const int row = row0 + ai * 128 + m * 16; const float rs = rsqrtf(ssv[ai][m] * (1.f / DM) + EPS); const float rs2 = -rs * 1.4426950408889634f;
                if (pn < 8) {
                    float o[8];
#pragma unroll
                    for (int n = 0; n < 2; ++n) {
                        const f32x4 v4 = acc[ai][0][m][n], t = acc[ai][1][m][n] * rs2; f32x4 e, r;
#pragma unroll
                        for (int j = 0; j < 4; ++j) e[j] = __builtin_amdgcn_exp2f(t[j]);
                        const f32x4 d = e + 1.0f;
#pragma unroll
                        for (int j = 0; j < 4; ++j) r[j] = __builtin_amdgcn_rcpf(d[j]);
                        const f32x4 q = v4 * (r * rs);
#pragma unroll
                        for (int j = 0; j < 4; ++j) o[4 * n + j] = q[j];
                    }
                    u32x4 w; w.x = pk2(o[0], o[1]); w.y = pk2(o[2], o[3]); w.z = pk2(o[4], o[5]); w.w = pk2(o[6], o[7]);
                    *(u32x4*)(AC + (size_t)row * 1024 + pn * 128 + wc * 32 + 8 * fq) = w;
                } else if (pn < 18) {
#pragma unroll
                    for (int bj = 0; bj < 2; ++bj) {
                        float o[8];
#pragma unroll
                        for (int n = 0; n < 2; ++n) {
                            const f32x4 a4 = acc[ai][bj][m][n]; f32x4 q;
                            if (pn < 12) {
                                const f32x4 t = a4 * rs2; f32x4 e, r;
#pragma unroll
                                for (int j = 0; j < 4; ++j) e[j] = __builtin_amdgcn_exp2f(t[j]);
                                const f32x4 d = e + 1.0f;
#pragma unroll
                                for (int j = 0; j < 4; ++j) r[j] = __builtin_amdgcn_rcpf(d[j]);
                                q = a4 * (r * rs);
                            } else q = a4 * rs;
#pragma unroll
                            for (int j = 0; j < 4; ++j) o[4 * n + j] = q[j];
                        }
                        u32x4 w; w.x = pk2(o[0], o[1]); w.y = pk2(o[2], o[3]); w.z = pk2(o[4], o[5]); w.w = pk2(o[6], o[7]);
                        const int cl = bj * 128 + wc * 32 + 8 * fq;
                        if (pn < 12) *(u32x4*)(Mz + (size_t)row * 2048 + 1024 + (pn - 8) * 256 + cl) = w;
                        else *(u32x4*)(XBC + (size_t)row * 1536 + (pn - 12) * 256 + cl) = w;
                    }
                } else {
                    if (wc == 0 && fq < 2) { *(f32x4*)(DTR + (size_t)row * 16 + 8 * fq) = acc[ai][0][m][0] * rs; *(f32x4*)(DTR + (size_t)row * 16 + 8 * fq + 4) = acc[ai][0][m][1] * rs; }
                }
            }
    }
};
struct EpiProj {
    bf16_t* O;
    __device__ __forceinline__ void operator()(const Acc& acc, const Unit& u, int wr, int wc, int fr, int fq) const {
        const int row0 = u.pm * 256 + wr * 64 + fr, col0 = u.pn * 256 + wc * 32 + 8 * fq;
#pragma unroll
        for (int ai = 0; ai < 2; ++ai)
#pragma unroll
            for (int m = 0; m < 4; ++m)
#pragma unroll
                for (int bj = 0; bj < 2; ++bj) {
                    const f32x4 v0 = acc[ai][bj][m][0], v1 = acc[ai][bj][m][1];
                    u32x4 w; w.x = pk2(v0[0], v0[1]); w.y = pk2(v0[2], v0[3]); w.z = pk2(v1[0], v1[1]); w.w = pk2(v1[2], v1[3]);
                    *(u32x4*)(O + (size_t)(row0 + ai * 128 + m * 16) * DM + col0 + bj * 128) = w;
                }
    }
};
struct EpiPle {
    const float* ss; const bf16_t* P; const bf16_t* HBr; bf16_t* H4; float* ssn; float mul;
    __device__ __forceinline__ void operator()(const Acc& acc, const Unit& u, int wr, int wc, int fr, int fq) const {
        const int row0 = u.pm * 256 + wr * 64 + fr, col0 = u.pn * 256 + wc * 32 + 8 * fq;
#pragma unroll
        for (int ai = 0; ai < 2; ++ai)
#pragma unroll
            for (int mp = 0; mp < 2; ++mp) {
                f32x4 hb[2][2][2]; u32x4 pw[2][2]; float rsv[2];
#pragma unroll
                for (int mm = 0; mm < 2; ++mm) { const int row = row0 + ai * 128 + (2 * mp + mm) * 16; rsv[mm] = rsqrtf(ss[row] * (1.f / DM) + EPS);
#pragma unroll
                    for (int bj = 0; bj < 2; ++bj) { const u32x4 r = *(const u32x4*)(HBr + (size_t)row * DM + col0 + bj * 128);
                        hb[mm][bj][0] = (f32x4){bflo(r.x), bfhi(r.x), bflo(r.y), bfhi(r.y)}; hb[mm][bj][1] = (f32x4){bflo(r.z), bfhi(r.z), bflo(r.w), bfhi(r.w)};
                        pw[mm][bj] = *(const u32x4*)(P + (size_t)row * DM + col0 + bj * 128); } }
#pragma unroll
                for (int mm = 0; mm < 2; ++mm) { const int m = 2 * mp + mm; const int row = row0 + ai * 128 + m * 16; const float rs = rsv[mm]; const float rs2 = -rs * 1.4426950408889634f;
                    float q = 0.f;
#pragma unroll
                    for (int bj = 0; bj < 2; ++bj) {
                        const u32x4 p4 = pw[mm][bj]; const f32x4 b0 = hb[mm][bj][0], b1 = hb[mm][bj][1]; const float mu = mul;
                        const f32x4 t0 = acc[ai][bj][m][0] * rs2, t1 = acc[ai][bj][m][1] * rs2; f32x4 e0, e1, r0, r1;
#pragma unroll
                        for (int j = 0; j < 4; ++j) { e0[j] = __builtin_amdgcn_exp2f(t0[j]); e1[j] = __builtin_amdgcn_exp2f(t1[j]); }
                        const f32x4 d0 = e0 + 1.0f, d1 = e1 + 1.0f;
#pragma unroll
                        for (int j = 0; j < 4; ++j) { r0[j] = __builtin_amdgcn_rcpf(d0[j]); r1[j] = __builtin_amdgcn_rcpf(d1[j]); }
                        const f32x4 pj0 = (f32x4){bflo(p4.x), bfhi(p4.x), bflo(p4.y), bfhi(p4.y)} * mu, pj1 = (f32x4){bflo(p4.z), bfhi(p4.z), bflo(p4.w), bfhi(p4.w)} * mu;
                        const f32x4 v0 = b0 + r0 * pj0, v1 = b1 + r1 * pj1;
                        { u32x4 w; w.x = pk2(v0[0], v0[1]); w.y = pk2(v0[2], v0[3]); w.z = pk2(v1[0], v1[1]); w.w = pk2(v1[2], v1[3]); *(u32x4*)(H4 + (size_t)row * DM + col0 + bj * 128) = w; }
                        q += (v0[0] * v0[0] + v0[1] * v0[1]) + (v0[2] * v0[2] + v0[3] * v0[3]) + (v1[0] * v1[0] + v1[1] * v1[1]) + (v1[2] * v1[2] + v1[3] * v1[3]);
                    }
                    q += __shfl_xor(q, 16); q += __shfl_xor(q, 32);
                    if (fq == 0) unsafeAtomicAdd(ssn + row, q);
                }
                asm volatile("" ::: "memory");
            }
    }
};

#define XB_TMO      128
#define XB_XCNT(j)  (256  + 64 * (j))
#define XB_XSUB(j)  (1280 + 64 * (j))
#define XB_XGEN(j)  (2304 + 64 * (j))
#define XB_TOP      3328
#define XB_TOPGEN   3392
#define XCD_BAR_WORDS 3456
#define XB_SPIN_CAP (1u << 18)

__device__ __forceinline__ unsigned xb_ld(unsigned* p)              { return __hip_atomic_load(p, __ATOMIC_RELAXED, __HIP_MEMORY_SCOPE_AGENT); }
__device__ __forceinline__ unsigned xb_add(unsigned* p, unsigned v) { return __hip_atomic_fetch_add(p, v, __ATOMIC_RELAXED, __HIP_MEMORY_SCOPE_AGENT); }
__device__ __forceinline__ unsigned xb_xcc_id() { return (unsigned)__builtin_amdgcn_s_getreg((3 << 11) | 20) & 0xFu; }
#define XB_SPIN(cond, bar) do { unsigned _sp = 0; while (cond) { __builtin_amdgcn_s_sleep(1); \
    if ((++_sp & 255u) == 0u) { if (xb_ld(&(bar)[XB_TMO])) break; if (_sp > XB_SPIN_CAP) { atomicAdd(&(bar)[XB_TMO], 1u); break; } } } } while (0)

struct XcdBarrier {
    unsigned* bar; unsigned x;
    volatile LAS unsigned* st;
};

__device__ __forceinline__ XcdBarrier xcd_barrier_post(unsigned* bar, volatile LAS unsigned* st) {
    XcdBarrier b; b.bar = bar; b.x = xb_xcc_id(); b.st = st;
    if (threadIdx.x == 0) (void)xb_add(&bar[XB_XCNT(b.x)], 1u);
    return b;
}
__device__ __forceinline__ void xcd_barrier_complete(unsigned* bar, unsigned x, unsigned& nloc, unsigned& nx) {
    const unsigned G = gridDim.x * gridDim.y * gridDim.z;
    unsigned sum, cnt, mine, sp = 0u;
    for (;;) {
        sum = 0u; cnt = 0u; mine = 0u;
#pragma unroll
        for (unsigned j = 0; j < 16; ++j) { const unsigned c = xb_ld(&bar[XB_XCNT(j)]); sum += c; cnt += (c > 0u) ? 1u : 0u; mine = (j == x) ? c : mine; }
        if (sum == G) break;
        __builtin_amdgcn_s_sleep(1);
        if ((++sp & 255u) == 0u) { if (xb_ld(&bar[XB_TMO])) break; if (sp > XB_SPIN_CAP) { atomicAdd(&bar[XB_TMO], 1u); break; } }
    }
    nloc = mine > 0u ? mine : 1u; nx = cnt > 0u ? cnt : 1u;
}

__device__ __forceinline__ void xcd_barrier(const XcdBarrier& b) {
    asm volatile("s_waitcnt vmcnt(0)" ::: "memory");
    __syncthreads();
    if (threadIdx.x == 0) {
        unsigned* bar = b.bar;
        __builtin_amdgcn_s_waitcnt(0);
        unsigned nloc = b.st[0], nx = b.st[1];
        if (nloc == 0u) { xcd_barrier_complete(bar, b.x, nloc, nx); b.st[0] = nloc; b.st[1] = nx; }
        const unsigned old = xb_add(&bar[XB_XSUB(b.x)], 1u);
        const unsigned gen = old / nloc;
        if (old + 1u == (gen + 1u) * nloc) {
            __builtin_amdgcn_fence(__ATOMIC_RELEASE, "agent");
            asm volatile("s_waitcnt vmcnt(0)" ::: "memory");
            const unsigned og = xb_add(&bar[XB_TOP], 1u);
            const unsigned tg = og / nx;
            if (og + 1u == (tg + 1u) * nx) xb_add(&bar[XB_TOPGEN], 1u);
            else XB_SPIN(xb_ld(&bar[XB_TOPGEN]) == tg, bar);
            __builtin_amdgcn_fence(__ATOMIC_ACQUIRE, "agent");
            xb_add(&bar[XB_XGEN(b.x)], 1u);
            asm volatile("s_waitcnt vmcnt(0)" ::: "memory");
        } else {
            XB_SPIN(xb_ld(&bar[XB_XGEN(b.x)]) == gen, bar);
            __builtin_amdgcn_fence(__ATOMIC_ACQUIRE, "agent");
            asm volatile("s_waitcnt vmcnt(0)" ::: "memory");
        }
    }
    __syncthreads();
}

struct Args { const float* in[32]; float* out; unsigned char* ws; int ph_lo, ph_hi; };
struct Frame {
    unsigned char* lds; int tid, lane, wave, gw, ngw;
    const float* const* in; float* out; unsigned char* ws;
};
__device__ __forceinline__ size_t xt_off(int row0, int c) { return (size_t)(row0 + (c >> 4)) * 2048 + (size_t)(c & 15) * 64; }
__device__ __forceinline__ int chunk_row0(int ch) { return ch < NCHP ? ch * 64 : NPR + (ch - NCHP) * 64; }

__device__ __forceinline__ void tr_item(const float* __restrict__ W, int K, int N, const float* __restrict__ gain, bf16_t* WT, int drow0, int k0, int n0, float* scr, int lane) {
    float v[32], gv[32];
#pragma unroll
    for (int i = 0; i < 32; ++i) { const int kk = 2 * i + (lane >> 5); v[i] = W[(size_t)(k0 + kk) * N + n0 + (lane & 31)]; gv[i] = gain ? gain[k0 + kk] : 1.f; }
    asm volatile("" ::: "memory"); __builtin_amdgcn_sched_barrier(0);
#pragma unroll
    for (int i = 0; i < 32; ++i) { const int kk = 2 * i + (lane >> 5); scr[kk * 33 + (lane & 31)] = v[i] * gv[i]; }
    asm volatile("s_waitcnt lgkmcnt(0)" ::: "memory");
    const int c = lane & 7;
#pragma unroll
    for (int j = 0; j < 4; ++j) { const int n = (lane >> 3) + 8 * j; const float* s = scr + (8 * c) * 33 + n;
        u32x4 o; o.x = pk2(s[0 * 33], s[1 * 33]); o.y = pk2(s[2 * 33], s[3 * 33]); o.z = pk2(s[4 * 33], s[5 * 33]); o.w = pk2(s[6 * 33], s[7 * 33]);
        *(u32x4*)(WT + (size_t)(drow0 + n) * K + k0 + 8 * c) = o; }
    asm volatile("s_waitcnt lgkmcnt(0)" ::: "memory");
}
__device__ __forceinline__ int dest_gu(int n0, int up) { return 256 * (n0 >> 7) + (n0 & 127) + (up ? 128 : 0); }
__device__ __forceinline__ int dest_in(int n0) { if (n0 < 1024) return 256 * (n0 >> 7) + (n0 & 127); if (n0 < 2048) { const int q = n0 - 1024; return 256 * (q >> 7) + 128 + (q & 127); } return n0; }
__device__ __forceinline__ void tr_matrix_item(const float* W, int K, int N, int NB, const float* gain, bf16_t* WT, int mode, int item, float* scr, int lane) {
    const int kb = item / NB, nb = item % NB, k0 = 64 * kb, n0 = 32 * nb;
    const int d = mode == 0 ? n0 : (mode == 1 ? dest_gu(n0, 0) : (mode == 2 ? dest_gu(n0, 1) : dest_in(n0)));
    tr_item(W, K, N, gain, WT, d, k0, n0, scr, lane);
}
constexpr int I_G = 16 * 88, I_D = 44 * 32, I_IN = 16 * 144, I_O = 32 * 32, I_PG = 16 * 32, I_PP = 4 * 32;
constexpr int NITEMS = 6 * I_G + I_IN + I_O + I_PG + I_PP;
static_assert(I_G == I_D, "");
__device__ __forceinline__ void p0_range(const Frame& F, int it_lo, int it_hi, int vw, int nvw) {
    float* scr = (float*)(F.lds + F.wave * 16384);
    bf16_t* Wgu1 = (bf16_t*)(F.ws + WS_WGU1); bf16_t* Wd1 = (bf16_t*)(F.ws + WS_WD1); bf16_t* Win = (bf16_t*)(F.ws + WS_WIN); bf16_t* Wout = (bf16_t*)(F.ws + WS_WOUT);
    bf16_t* Wgu2 = (bf16_t*)(F.ws + WS_WGU2); bf16_t* Wd2 = (bf16_t*)(F.ws + WS_WD2); bf16_t* Wpg = (bf16_t*)(F.ws + WS_WPG); bf16_t* Wpp = (bf16_t*)(F.ws + WS_WPP);
    for (int it = it_lo + vw; it < it_hi; it += nvw) {
        int r = it;
        if (r < I_G) { tr_matrix_item(F.in[8], DM, FF, 88, F.in[7], Wgu1, 1, r, scr, F.lane); continue; } r -= I_G;
        if (r < I_G) { tr_matrix_item(F.in[9], DM, FF, 88, F.in[7], Wgu1, 2, r, scr, F.lane); continue; } r -= I_G;
        if (r < I_D) { tr_matrix_item(F.in[10], FF, DM, 32, nullptr, Wd1, 0, r, scr, F.lane); continue; } r -= I_D;
        if (r < I_G) { tr_matrix_item(F.in[25], DM, FF, 88, F.in[24], Wgu2, 1, r, scr, F.lane); continue; } r -= I_G;
        if (r < I_G) { tr_matrix_item(F.in[26], DM, FF, 88, F.in[24], Wgu2, 2, r, scr, F.lane); continue; } r -= I_G;
        if (r < I_D) { tr_matrix_item(F.in[27], FF, DM, 32, nullptr, Wd2, 0, r, scr, F.lane); continue; } r -= I_D;
        if (r < I_IN) { tr_matrix_item(F.in[12], DM, NINR, 144, F.in[11], Win, 3, r, scr, F.lane); continue; } r -= I_IN;
        if (r < I_O) { tr_matrix_item(F.in[23], 2048, DM, 32, (r / 32) >= 16 ? F.in[22] - 1024 : nullptr, Wout, 0, r, scr, F.lane); continue; } r -= I_O;
        if (r < I_PG) { tr_matrix_item(F.in[30], DM, DM, 32, F.in[28], Wpg, 0, r, scr, F.lane); continue; } r -= I_PG;
        tr_matrix_item(F.in[29], 256, DM, 32, nullptr, Wpp, 0, r, scr, F.lane);
    }
}
__device__ __forceinline__ void p0_dtcols(const Frame& F, int vw, int nvw) {
    bf16_t* Win = (bf16_t*)(F.ws + WS_WIN);
    for (int idx = vw * 64 + F.lane; idx < 16 * DM; idx += nvw * 64) { const int n = idx >> 10, k = idx & 1023; Win[(size_t)(4608 + n) * DM + k] = f2bf(F.in[12][(size_t)k * NINR + 4608 + n] * F.in[11][k]); }
}
__device__ __forceinline__ void p0_xb(const Frame& F) {
    bf16_t* HB = (bf16_t*)(F.ws + WS_HB); float* ss1 = (float*)(F.ws + WS_CTL);
    for (int m0 = F.gw; m0 < MT; m0 += 4 * F.ngw) {
        f32x4 v[4][4];
#pragma unroll
        for (int q = 0; q < 4; ++q) { const int m = m0 + q * F.ngw; if (m < MT) { const float* xr = m < NPR ? F.in[0] + (size_t)m * DM : F.in[1] + (size_t)(m - NPR) * DM;
#pragma unroll
            for (int j = 0; j < 4; ++j) v[q][j] = *(const f32x4*)(xr + 4 * F.lane + 256 * j); } }
#pragma unroll
        for (int q = 0; q < 4; ++q) { const int m = m0 + q * F.ngw; if (m < MT) { float s = 0.f;
#pragma unroll
            for (int j = 0; j < 4; ++j) { const f32x4 w4 = v[q][j]; s += (w4[0] * w4[0] + w4[1] * w4[1]) + (w4[2] * w4[2] + w4[3] * w4[3]);
                u32x2 w; w.x = pk2(w4[0], w4[1]); w.y = pk2(w4[2], w4[3]); *(u32x2*)(HB + (size_t)m * DM + 4 * F.lane + 256 * j) = w; }
            s = wave_sum(s); if (F.lane == 0) ss1[m] = s; } }
    }
}
__device__ __forceinline__ bool tail_idle(int nwg, int G, int c, int& e, int& ne) {
    const int R = (nwg + G - 1) / G, c0 = nwg - (R - 1) * G;
    if (c0 >= G) { e = c; ne = G; return true; }
    e = c - c0; ne = G - c0; return c >= c0;
}
__device__ __forceinline__ void cvt_pb(const Frame& F) {
    bf16_t* PB = (bf16_t*)(F.ws + WS_PB);
    for (int m0 = F.gw; m0 < MT; m0 += 4 * F.ngw) {
        f32x4 v[4];
#pragma unroll
        for (int q = 0; q < 4; ++q) { const int m = m0 + q * F.ngw; if (m < MT) v[q] = *(const f32x4*)((m < NPR ? F.in[2] + (size_t)m * 256 : F.in[3] + (size_t)(m - NPR) * 256) + 4 * F.lane); }
#pragma unroll
        for (int q = 0; q < 4; ++q) { const int m = m0 + q * F.ngw; if (m < MT) { u32x2 w; w.x = pk2(v[q][0], v[q][1]); w.y = pk2(v[q][2], v[q][3]); *(u32x2*)(PB + (size_t)m * 256 + 4 * F.lane) = w; } }
    }
}

__device__ __forceinline__ void s0_load(const Frame& F, int ch, int part, u32x4 (&raw)[11]) {
    const int row0 = chunk_row0(ch); const bool smp = ch >= NCHP; const int b = smp ? ch - NCHP : ch >> 8; const int tl0 = smp ? 0 : (ch & 255) * 64;
    const bf16_t* XBC = (const bf16_t*)(F.ws + WS_XBC);
    const int rg = F.tid & 7, c0 = (part * 64 + (F.tid >> 3)) * 8, s0 = rg * 8;
    if (tl0 > 0) {
#pragma unroll
        for (int i = 0; i < 11; ++i) raw[i] = *(const u32x4*)(XBC + (size_t)(row0 + s0 - 3 + i) * 1536 + c0);
    } else {
#pragma unroll
        for (int i = 0; i < 11; ++i) {
            const int s = s0 - 3 + i;
            if (s >= 0) raw[i] = *(const u32x4*)(XBC + (size_t)(row0 + s) * 1536 + c0);
            else if (smp) { const float* sp = F.in[5] + (size_t)(b * 3 + (s + 3)) * 1536 + c0; const f32x4 a0 = *(const f32x4*)sp, a1 = *(const f32x4*)(sp + 4);
                raw[i] = (u32x4){pk2(a0[0], a0[1]), pk2(a0[2], a0[3]), pk2(a1[0], a1[1]), pk2(a1[2], a1[3])}; }
            else raw[i] = (u32x4){0u, 0u, 0u, 0u};
        }
    }
}
__device__ __forceinline__ void s0_compute(const Frame& F, int ch, int part, const u32x4 (&raw)[11], const float (&w)[4][8], const float (&bs)[8]) {
    const int row0 = chunk_row0(ch); const bool smp = ch >= NCHP; const int b = smp ? ch - NCHP : ch >> 8;
    const bool lastc = smp || (ch & 255) == 255;
    bf16_t* XT = (bf16_t*)(F.ws + WS_M); bf16_t* Bn = (bf16_t*)(F.ws + WS_BN); bf16_t* BT = (bf16_t*)(F.ws + WS_BT); bf16_t* Cn = (bf16_t*)(F.ws + WS_CN);
    const int rg = F.tid & 7, c0 = (part * 64 + (F.tid >> 3)) * 8, s0 = rg * 8;
    if (part == 0) {
        const float* DTR = (const float*)(F.ws + WS_DTR); float* DT = (float*)(F.ws + WS_DT); float* ACU = (float*)(F.ws + WS_ACU);
        const size_t ro = (size_t)(row0 + F.lane) * 16 + 2 * F.wave;
        const f32x2 rw = *(const f32x2*)(DTR + ro), bi = *(const f32x2*)(F.in[19] + 2 * F.wave), al = *(const f32x2*)(F.in[20] + 2 * F.wave);
        f32x2 dv, av;
#pragma unroll
        for (int j = 0; j < 2; ++j) { const float x = rw[j] + bi[j]; const float e = __expf(x); const float d = x > 20.f ? x : (e < 1e-3f ? e * (1.f - 0.5f * e + 0.33333333f * e * e) : __logf(1.f + e)); dv[j] = d; float a = -__expf(al[j]) * d;
#pragma unroll
            for (int o = 1; o < 64; o <<= 1) { const float t = __shfl_up(a, o); if (F.lane >= o) a += t; }
            av[j] = a; }
        *(f32x2*)(DT + ro) = dv; *(f32x2*)(ACU + ro) = av;
    }
    float x[4][8];
#pragma unroll
    for (int i = 0; i < 3; ++i) { const u32x4 r = raw[i]; x[i][0] = bflo(r.x); x[i][1] = bfhi(r.x); x[i][2] = bflo(r.y); x[i][3] = bfhi(r.y); x[i][4] = bflo(r.z); x[i][5] = bfhi(r.z); x[i][6] = bflo(r.w); x[i][7] = bfhi(r.w); }
    unsigned tp[8][4];
    bf16_t* nat = c0 < 1280 ? Bn + (c0 - 1024) : Cn + (c0 - 1280);
#pragma unroll
    for (int q = 0; q < 4; ++q) {
        float y[2][8];
#pragma unroll
        for (int e = 0; e < 2; ++e) {
            const int i = 2 * q + e; const u32x4 r = raw[i + 3];
            float xn[8]; xn[0] = bflo(r.x); xn[1] = bfhi(r.x); xn[2] = bflo(r.y); xn[3] = bfhi(r.y); xn[4] = bflo(r.z); xn[5] = bfhi(r.z); xn[6] = bflo(r.w); xn[7] = bfhi(r.w);
#pragma unroll
            for (int j = 0; j < 8; ++j) { const float v = bs[j] + w[0][j] * x[0][j] + w[1][j] * x[1][j] + w[2][j] * x[2][j] + w[3][j] * xn[j]; y[e][j] = v * sigm(v); x[0][j] = x[1][j]; x[1][j] = x[2][j]; x[2][j] = xn[j]; }
            if (part == 2) { u32x4 o; o.x = pk2(y[e][0], y[e][1]); o.y = pk2(y[e][2], y[e][3]); o.z = pk2(y[e][4], y[e][5]); o.w = pk2(y[e][6], y[e][7]); *(u32x4*)(nat + (size_t)(row0 + s0 + i) * 256) = o; }
        }
#pragma unroll
        for (int j = 0; j < 8; ++j) tp[j][q] = pk2(y[0][j], y[1][j]);
    }
    if (c0 < 1280) {
        bf16_t* dst = c0 < 1024 ? XT + xt_off(row0, c0) + s0 : BT + ((size_t)ch * 256 + (c0 - 1024)) * 64 + s0;
#pragma unroll
        for (int j = 0; j < 8; ++j) *(u32x4*)(dst + (size_t)j * 64) = (u32x4){tp[j][0], tp[j][1], tp[j][2], tp[j][3]};
    }
    if (lastc && rg == 7) {
        float* o = F.out + (smp ? O_XS : O_XP) + (size_t)b * 3 * 1536 + c0;
#pragma unroll
        for (int i = 0; i < 3; ++i) { const u32x4 r = raw[8 + i]; *(f32x4*)(o + (size_t)i * 1536) = (f32x4){bflo(r.x), bfhi(r.x), bflo(r.y), bfhi(r.y)}; *(f32x4*)(o + (size_t)i * 1536 + 4) = (f32x4){bflo(r.z), bfhi(r.z), bflo(r.w), bfhi(r.w)}; }
    }
}
__device__ __forceinline__ void s0_phase(const Frame& F) {
    const int G = gridDim.x, bid = blockIdx.x, part = bid % 3, rank = bid / 3, nb = (G - part + 2) / 3;
    if (G < 3) { return; }
    const float* cw = F.in[17]; const float* cbias = F.in[18];
    const int c0 = (part * 64 + (F.tid >> 3)) * 8;
    float w[4][8], bs[8];
#pragma unroll
    for (int k = 0; k < 4; ++k) { const f32x4 a = *(const f32x4*)(cw + k * 1536 + c0), bq = *(const f32x4*)(cw + k * 1536 + c0 + 4);
#pragma unroll
        for (int j = 0; j < 4; ++j) { w[k][j] = a[j]; w[k][4 + j] = bq[j]; } }
    { const f32x4 a = *(const f32x4*)(cbias + c0), bq = *(const f32x4*)(cbias + c0 + 4);
#pragma unroll
      for (int j = 0; j < 4; ++j) { bs[j] = a[j]; bs[4 + j] = bq[j]; } }
    u32x4 ra[11], rb[11];
    int ch = rank;
    if (ch < NCH) s0_load(F, ch, part, ra);
    for (; ch < NCH; ch += nb) {
        const int chn = ch + nb;
        if (chn < NCH) s0_load(F, chn, part, rb);
        s0_compute(F, ch, part, ra, w, bs);
#pragma unroll
        for (int i = 0; i < 11; ++i) ra[i] = rb[i];
    }
}
__device__ __forceinline__ void cv_unit(const Frame& F, int u, const f32x2 (&ww)[31], const f32x2 bb, const f32x4 (&lg)[4], const f32x4 (&lb)[4]) {
    const int row0 = u * 16; const bool smp = row0 >= NPR; const int b = smp ? (row0 - NPR) >> 6 : row0 >> 14; const int tl0 = smp ? (row0 - NPR) & 63 : row0 & (SEQ - 1); const int T = smp ? 64 : SEQ;
    const bf16_t* AC = (const bf16_t*)(F.ws + WS_AC); bf16_t* Mo = (bf16_t*)(F.ws + WS_M); const float* ssd = (const float*)(F.ws + WS_CTL) + 5 * MT;
    const int c0 = 2 * F.tid;
    f32x2 w[46];
    if (tl0 >= 30) {
        unsigned r[46];
#pragma unroll
        for (int j = 0; j < 46; ++j) r[j] = *(const unsigned*)(AC + (size_t)(row0 - 30 + j) * 1024 + c0);
#pragma unroll
        for (int j = 0; j < 46; ++j) w[j] = (f32x2){bflo(r[j]), bfhi(r[j])};
    } else {
#pragma unroll
        for (int j = 0; j < 46; ++j) {
            const int tl = tl0 - 30 + j;
            if (tl >= 0) { const unsigned r = *(const unsigned*)(AC + (size_t)(row0 - 30 + j) * 1024 + c0); w[j] = (f32x2){bflo(r), bfhi(r)}; }
            else if (smp) { w[j] = *(const f32x2*)(F.in[4] + (size_t)(b * 30 + 30 + tl) * 1024 + c0); }
            else { w[j] = (f32x2){0.f, 0.f}; }
        }
    }
    f32x2 a[16];
#pragma unroll
    for (int t = 0; t < 16; ++t) a[t] = bb;
#pragma unroll
    for (int k = 0; k < 31; ++k) {
#pragma unroll
        for (int t = 0; t < 16; ++t) a[t] = __builtin_elementwise_fma(ww[k], w[t + k], a[t]); }
    float* L = (float*)F.lds;
#pragma unroll
    for (int t = 0; t < 16; ++t) *(f32x2*)(L + t * 1024 + c0) = a[t];
    if (tl0 + 16 > T - 30) { float* o = F.out + (smp ? O_CS : O_CP) + (size_t)b * 30 * 1024 + c0;
#pragma unroll
        for (int t = 0; t < 16; ++t) { const int q = tl0 + t - (T - 30); if (q >= 0) *(f32x2*)(o + (size_t)q * 1024) = w[30 + t]; } }
    __syncthreads();
#pragma unroll
    for (int tt = 0; tt < 2; ++tt) {
        const int t = 2 * F.wave + tt; f32x4 v[4]; float s = 0.f;
        const float inv = sqrtf(ssd[row0 + t] * (1.f / 1024.f) + EPS);
#pragma unroll
        for (int i = 0; i < 4; ++i) { v[i] = *(const f32x4*)(L + t * 1024 + 4 * F.lane + 256 * i); s += (v[i][0] + v[i][1]) + (v[i][2] + v[i][3]); }
        const float mean = wave_sum(s) * (1.f / 1024.f); float q = 0.f;
#pragma unroll
        for (int i = 0; i < 4; ++i) { v[i] = v[i] - mean; q += (v[i][0] * v[i][0] + v[i][1] * v[i][1]) + (v[i][2] * v[i][2] + v[i][3] * v[i][3]); }
        const float rstd = rsqrtf(wave_sum(q) * (1.f / 1024.f) + EPS);
#pragma unroll
        for (int i = 0; i < 4; ++i) { const int c = 4 * F.lane + 256 * i;
            float o[4];
#pragma unroll
            for (int j = 0; j < 4; ++j) { const float z = v[i][j] * rstd * lg[i][j] + lb[i][j]; o[j] = z * sigm(z) * inv; }
            u32x2 wv; wv.x = pk2(o[0], o[1]); wv.y = pk2(o[2], o[3]); *(u32x2*)(Mo + (size_t)(row0 + t) * 2048 + c) = wv; }
    }
    __syncthreads();
}
__device__ __forceinline__ void cv_phase(const Frame& F) {
    f32x2 ww[31]; f32x4 lg[4], lb[4];
    const int c0 = 2 * F.tid;
#pragma unroll
    for (int k = 0; k < 31; ++k) ww[k] = *(const f32x2*)(F.in[13] + k * 1024 + c0);
    const f32x2 bb = *(const f32x2*)(F.in[14] + c0);
#pragma unroll
    for (int i = 0; i < 4; ++i) { lg[i] = *(const f32x4*)(F.in[15] + 4 * F.lane + 256 * i); lb[i] = *(const f32x4*)(F.in[16] + 4 * F.lane + 256 * i); }
    for (int u = blockIdx.x; u < MT / 16; u += gridDim.x) cv_unit(F, u, ww, bb, lg, lb);
}
__device__ __forceinline__ void s1_unit(const Frame& F, int ub) {
    const int ch = ub >> 1, g = ub & 1, h = g * 8 + F.wave, row0 = chunk_row0(ch), l31 = F.lane & 31, hi = F.lane >> 5;
    const bf16_t* XT = (const bf16_t*)(F.ws + WS_M); const bf16_t* BT = (const bf16_t*)(F.ws + WS_BT); bf16_t* L = (bf16_t*)(F.ws + WS_L);
    const float* DT = (const float*)(F.ws + WS_DT); const float* ACU = (const float*)(F.ws + WS_ACU);
    bf16_t* Bs = (bf16_t*)F.lds;
    bf16_t* Sw = (bf16_t*)(F.lds + 20480 + F.wave * 8192);
    const int prow = F.lane >> 3, pq = F.lane & 7;
    const float ac = ACU[(size_t)(row0 + F.lane) * 16 + h], dv = DT[(size_t)(row0 + F.lane) * 16 + h];
    u32x4 bt[2], xt[8];
#pragma unroll
    for (int i = 0; i < 2; ++i) { const int p = F.tid + 512 * i; bt[i] = *(const u32x4*)(BT + ((size_t)ch * 256 + g * 128 + (p >> 3)) * 64 + (p & 7) * 8); }
#pragma unroll
    for (int i = 0; i < 8; ++i) xt[i] = *(const u32x4*)(XT + xt_off(row0, h * 64 + 8 * i + prow) + pq * 8);
#pragma unroll
    for (int i = 0; i < 2; ++i) { const int p = F.tid + 512 * i; *(u32x4*)(Bs + (p >> 3) * 72 + (p & 7) * 8) = bt[i]; }
#pragma unroll
    for (int i = 0; i < 8; ++i) { const int r = 8 * i + prow; *(u32x4*)(Sw + r * 64 + ((pq ^ (r & 7)) * 8)) = xt[i]; }
    const float we = __expf(__shfl(ac, 63) - ac) * dv;
    __syncthreads();
    f32x16 acc[2][4];
#pragma unroll
    for (int i = 0; i < 2; ++i)
#pragma unroll
        for (int j = 0; j < 4; ++j)
#pragma unroll
            for (int r = 0; r < 16; ++r) acc[i][j][r] = 0.f;
#pragma unroll
    for (int ks = 0; ks < 4; ++ks) {
        const int c = 2 * ks + hi;
        u32x4 xr[2]; bf16x8 bfr[4];
#pragma unroll
        for (int it = 0; it < 2; ++it) xr[it] = *(const u32x4*)(Sw + (32 * it + l31) * 64 + ((c ^ (l31 & 7)) * 8));
#pragma unroll
        for (int jt = 0; jt < 4; ++jt) bfr[jt] = *(const bf16x8*)(Bs + (32 * jt + l31) * 72 + 16 * ks + 8 * hi);
        float sc[8];
#pragma unroll
        for (int j = 0; j < 8; ++j) sc[j] = __shfl(we, 16 * ks + 8 * hi + j);
        bf16x8 af[2];
#pragma unroll
        for (int it = 0; it < 2; ++it) { const u32x4 r = xr[it];
            u32x4 o; o.x = pk2(bflo(r.x) * sc[0], bfhi(r.x) * sc[1]); o.y = pk2(bflo(r.y) * sc[2], bfhi(r.y) * sc[3]); o.z = pk2(bflo(r.z) * sc[4], bfhi(r.z) * sc[5]); o.w = pk2(bflo(r.w) * sc[6], bfhi(r.w) * sc[7]);
            af[it] = __builtin_bit_cast(bf16x8, o); }
#pragma unroll
        for (int it = 0; it < 2; ++it)
#pragma unroll
            for (int jt = 0; jt < 4; ++jt) acc[it][jt] = MFMA32(af[it], bfr[jt], acc[it][jt]);
        asm volatile("" ::: "memory");
    }
    __syncthreads();
    bf16_t* T = (bf16_t*)(F.lds + F.wave * 16384);
#pragma unroll
    for (int it = 0; it < 2; ++it)
#pragma unroll
        for (int jt = 0; jt < 4; ++jt)
#pragma unroll
            for (int r = 0; r < 16; ++r) T[(32 * it + crow(r, hi)) * 128 + 32 * jt + l31] = f2bf(acc[it][jt][r]);
    asm volatile("s_waitcnt lgkmcnt(0)" ::: "memory");
    bf16_t* Lo = L + ((size_t)ch * 16 + h) * 8192;
#pragma unroll
    for (int i = 0; i < 16; ++i) *(u32x4*)(Lo + (size_t)i * 512 + F.lane * 8) = *(const u32x4*)(T + i * 512 + F.lane * 8);
    asm volatile("s_waitcnt lgkmcnt(0)" ::: "memory");
    __syncthreads();
}
template <bool DRY> __device__ __forceinline__ void s2_phase(const Frame& F) {
    unsigned* Lw = (unsigned*)(F.ws + WS_L); const float* ACU = (const float*)(F.ws + WS_ACU);
    const int gt = blockIdx.x * 512 + F.tid, nt = gridDim.x * 512;
    for (int i = gt; i < 2 * 65536; i += nt) {
        const int b = i >> 16, q = i & 65535, h = q >> 12;
        float S0 = 0.f, S1 = 0.f;
        for (int c0 = 0; c0 < 256; c0 += 32) {
            unsigned lv[32]; float d[32];
#pragma unroll
            for (int k = 0; k < 32; ++k) { lv[k] = Lw[(size_t)(b * 256 + c0 + k) * 65536 + q]; d[k] = __expf(ACU[(size_t)(b * SEQ + (c0 + k) * 64 + 63) * 16 + h]); }
#pragma unroll
            for (int k = 0; k < 32; ++k) { Lw[(size_t)(b * 256 + c0 + k) * 65536 + q] = DRY ? lv[k] : pk2(S0, S1); S0 = S0 * d[k] + bflo(lv[k]); S1 = S1 * d[k] + bfhi(lv[k]); }
        }
        if (!DRY || S0 == 1.2345f) *(f32x2*)(F.out + O_SP + (size_t)b * 131072 + 2 * q) = (f32x2){S0, S1};
    }
    for (int i = gt; i < 16 * 65536; i += nt) {
        const int b = i >> 16, q = i & 65535, h = q >> 12;
        const f32x2 st = *(const f32x2*)(F.in[6] + (size_t)b * 131072 + 2 * q);
        const float d = __expf(ACU[(size_t)(NPR + b * 64 + 63) * 16 + h]);
        const unsigned lv = Lw[(size_t)(NCHP + b) * 65536 + q];
        Lw[(size_t)(NCHP + b) * 65536 + q] = DRY ? lv : pk2(st.x, st.y);
        if (!DRY || d == 1.2345f) *(f32x2*)(F.out + O_SS + (size_t)b * 131072 + 2 * q) = (f32x2){st.x * d + bflo(lv), st.y * d + bfhi(lv)};
    }
}
#define S3_TILE(CBV, SI, TI) do { \
    const int t_ = 32 * (TI) + l31; const float at_ = l_a[t_]; float wv[16]; \
    _Pragma("unroll") for (int r = 0; r < 16; ++r) { const int s_ = 32 * (SI) + crow(r, hi); const float as_ = l_a[s_], ds_ = l_a[64 + s_]; \
        float v_ = CBV[r] * __expf(fminf(at_ - as_, 0.f)) * ds_; v_ = (s_ <= t_) ? v_ : 0.f; if (s_ == t_) v_ += Dh; wv[r] = v_; } \
    _Pragma("unroll") for (int k2 = 0; k2 < 2; ++k2) { \
        u32x4 fw; fw.x = pk2(wv[8 * k2], wv[8 * k2 + 1]); fw.y = pk2(wv[8 * k2 + 2], wv[8 * k2 + 3]); fw.z = pk2(wv[8 * k2 + 4], wv[8 * k2 + 5]); fw.w = pk2(wv[8 * k2 + 6], wv[8 * k2 + 7]); \
        const bf16x8 wf = __builtin_bit_cast(bf16x8, fw); \
        _Pragma("unroll") for (int pj = 0; pj < 2; ++pj) { \
            const int row_ = 32 * pj + l31, e_ = 8 * (SI) + 4 * k2 + hi;             \
            const u32x2 lo_ = *(const u32x2*)(Sw + row_ * 64 + (((e_ >> 1) ^ (row_ & 7)) * 8) + (e_ & 1) * 4); \
            const u32x2 hi_ = *(const u32x2*)(Sw + row_ * 64 + ((((e_ + 2) >> 1) ^ (row_ & 7)) * 8) + (e_ & 1) * 4); \
            const u32x4 xw = (u32x4){lo_.x, lo_.y, hi_.x, hi_.y}; \
            y[TI][pj] = MFMA32(wf, __builtin_bit_cast(bf16x8, xw), y[TI][pj]); } } } while (0)
template <bool DRY> __device__ __forceinline__ void s3_unit(const Frame& F, int ub) {
    const int ch = ub >> 1, g = ub & 1, h = g * 8 + F.wave, row0 = chunk_row0(ch), l31 = F.lane & 31, hi = F.lane >> 5;
    const bf16_t* XT = (const bf16_t*)(F.ws + WS_M); const bf16_t* Bn = (const bf16_t*)(F.ws + WS_BN); const bf16_t* Cn = (const bf16_t*)(F.ws + WS_CN);
    const bf16_t* SP = (const bf16_t*)(F.ws + WS_L); bf16_t* Mo = (bf16_t*)(F.ws + WS_M); float* ssd = (float*)(F.ws + WS_CTL) + (DRY ? 6 : 5) * MT;
    float* Yw = (float*)(F.lds + F.wave * 16384); float* l_a = (float*)(F.lds + 131072 + F.wave * 512);
    bf16_t* Bs = (bf16_t*)F.lds; bf16_t* Cs = Bs + 64 * 136;
    bf16_t* Sw = (bf16_t*)(F.lds + 36864 + F.wave * 8192);
    const bf16_t* Sh = SP + ((size_t)ch * 16 + h) * 8192;
    const int prow = F.lane >> 3, pq = F.lane & 7;
    const float la0 = ((const float*)(F.ws + WS_ACU))[(size_t)(row0 + F.lane) * 16 + h], la1 = ((const float*)(F.ws + WS_DT))[(size_t)(row0 + F.lane) * 16 + h];
    u32x4 bc[4], st[8];
#pragma unroll
    for (int i = 0; i < 4; ++i) { const int p = F.tid + 512 * i, which = p >> 10, r = (p >> 4) & 63, c8 = (p & 15) * 8; bc[i] = *(const u32x4*)((which ? Cn : Bn) + (size_t)(row0 + r) * 256 + g * 128 + c8); }
#pragma unroll
    for (int i = 0; i < 8; ++i) st[i] = *(const u32x4*)(Sh + (size_t)(8 * i + prow) * 128 + pq * 8);
    l_a[F.lane] = la0; l_a[64 + F.lane] = la1;
#pragma unroll
    for (int i = 0; i < 4; ++i) { const int p = F.tid + 512 * i, which = p >> 10, r = (p >> 4) & 63, c8 = (p & 15) * 8; *(u32x4*)((which ? Cs : Bs) + r * 136 + c8) = bc[i]; }
#pragma unroll
    for (int i = 0; i < 8; ++i) { const int r = 8 * i + prow; *(u32x4*)(Sw + r * 64 + ((pq ^ (r & 7)) * 8)) = st[i]; }
    __syncthreads();
#pragma unroll
    for (int i = 0; i < 8; ++i) st[i] = *(const u32x4*)(Sh + (size_t)(8 * i + prow) * 128 + 64 + pq * 8);
    f32x16 cb00, cb01, cb11;
#pragma unroll
    for (int r = 0; r < 16; ++r) { cb00[r] = 0.f; cb01[r] = 0.f; cb11[r] = 0.f; }
    const bf16_t* Bp = Bs + l31 * 136 + 8 * hi; const bf16_t* Cp = Cs + l31 * 136 + 8 * hi;
#pragma unroll
    for (int ks = 0; ks < 8; ++ks) {
        const bf16x8 bf0 = *(const bf16x8*)(Bp + 16 * ks), bf1 = *(const bf16x8*)(Bp + 16 * ks + 32 * 136), cf0 = *(const bf16x8*)(Cp + 16 * ks), cf1 = *(const bf16x8*)(Cp + 16 * ks + 32 * 136);
        cb00 = MFMA32(bf0, cf0, cb00); cb01 = MFMA32(bf0, cf1, cb01); cb11 = MFMA32(bf1, cf1, cb11);
        if (ks & 1) asm volatile("" ::: "memory");
    }
    f32x16 y[2][2];
#pragma unroll
    for (int a = 0; a < 2; ++a)
#pragma unroll
        for (int bq = 0; bq < 2; ++bq)
#pragma unroll
            for (int r = 0; r < 16; ++r) y[a][bq][r] = 0.f;
#pragma unroll
    for (int kh = 0; kh < 2; ++kh) {
#pragma unroll
        for (int k = 0; k < 4; ++k) {
            const int ks = 4 * kh + k, c = 2 * k + hi;
            const bf16x8 cf0 = *(const bf16x8*)(Cp + 16 * ks), cf1 = *(const bf16x8*)(Cp + 16 * ks + 32 * 136);
            const bf16x8 sf0 = *(const bf16x8*)(Sw + l31 * 64 + ((c ^ (l31 & 7)) * 8)), sf1 = *(const bf16x8*)(Sw + (32 + l31) * 64 + ((c ^ (l31 & 7)) * 8));
            y[0][0] = MFMA32(cf0, sf0, y[0][0]); y[0][1] = MFMA32(cf0, sf1, y[0][1]); y[1][0] = MFMA32(cf1, sf0, y[1][0]); y[1][1] = MFMA32(cf1, sf1, y[1][1]);
            if (k & 1) asm volatile("" ::: "memory");
        }
#pragma unroll
        for (int i = 0; i < 8; ++i) { const int r = 8 * i + prow; *(u32x4*)(Sw + r * 64 + ((pq ^ (r & 7)) * 8)) = st[i]; }
        if (kh == 0) {
#pragma unroll
            for (int i = 0; i < 8; ++i) st[i] = *(const u32x4*)(XT + xt_off(row0, h * 64 + 8 * i + prow) + pq * 8);
        }
    }
#pragma unroll
    for (int ti = 0; ti < 2; ++ti)
#pragma unroll
        for (int r = 0; r < 16; ++r) { const float e = __expf(l_a[32 * ti + crow(r, hi)]); y[ti][0][r] *= e; y[ti][1][r] *= e; }
    const float Dh = F.in[21][h];
    const int p0 = 8 * (F.lane & 7);
    S3_TILE(cb00, 0, 0);
    S3_TILE(cb01, 0, 1);
    S3_TILE(cb11, 1, 1);
    __syncthreads();
    u32x4 zz[8];
#pragma unroll
    for (int it = 0; it < 8; ++it) zz[it] = *(const u32x4*)(Mo + (size_t)(row0 + it * 8 + (F.lane >> 3)) * 2048 + 1024 + h * 64 + p0);
#pragma unroll
    for (int ti = 0; ti < 2; ++ti)
#pragma unroll
        for (int pj = 0; pj < 2; ++pj)
#pragma unroll
            for (int r = 0; r < 16; ++r) Yw[(32 * ti + crow(r, hi)) * 64 + 32 * pj + l31] = y[ti][pj][r];
    asm volatile("s_waitcnt lgkmcnt(0)" ::: "memory");
#pragma unroll
    for (int it = 0; it < 8; ++it) {
        const int t = it * 8 + (F.lane >> 3);
        const f32x4 ya = *(const f32x4*)(Yw + t * 64 + p0), yb = *(const f32x4*)(Yw + t * 64 + p0 + 4);
        bf16_t* mp = Mo + (size_t)(row0 + t) * 2048 + 1024 + h * 64 + p0;
        const u32x4 z = zz[it];
        u32x4 o; o.x = pk2(ya[0] * bflo(z.x), ya[1] * bfhi(z.x)); o.y = pk2(ya[2] * bflo(z.y), ya[3] * bfhi(z.y)); o.z = pk2(yb[0] * bflo(z.z), yb[1] * bfhi(z.z)); o.w = pk2(yb[2] * bflo(z.w), yb[3] * bfhi(z.w));
        *(u32x4*)mp = DRY ? z : o;
        float q = (bflo(o.x) * bflo(o.x) + bfhi(o.x) * bfhi(o.x)) + (bflo(o.y) * bflo(o.y) + bfhi(o.y) * bfhi(o.y)) + (bflo(o.z) * bflo(o.z) + bfhi(o.z) * bfhi(o.z)) + (bflo(o.w) * bflo(o.w) + bfhi(o.w) * bfhi(o.w));
        q += __shfl_xor(q, 1); q += __shfl_xor(q, 2); q += __shfl_xor(q, 4);
        if ((F.lane & 7) == 0) unsafeAtomicAdd(ssd + row0 + t, q);
    }
    asm volatile("s_waitcnt lgkmcnt(0)" ::: "memory");
    __syncthreads();
}
template <bool DRY> __device__ __forceinline__ void final_phase(const Frame& F, int row_lo, int row_hi, int vw, int nvw, int mode = 0, unsigned long long mk0 = 0ull, unsigned long long mk1 = 0ull) {
#define FSEL(m) (mode == 0 || ((m) >= NPR ? mode == 2 : ((((((m) >> 8) < 64 ? mk0 >> ((m) >> 8) : mk1 >> (((m) >> 8) - 64)) & 1ull) != 0ull) == (mode == 2))))
    const float* ss5 = (const float*)(F.ws + WS_CTL) + 4 * MT; const bf16_t* H4 = (const bf16_t*)(F.ws + WS_ACT);
    f32x4 g[2][2];
#pragma unroll
    for (int j = 0; j < 2; ++j) { g[j][0] = *(const f32x4*)(F.in[31] + 8 * F.lane + 512 * j); g[j][1] = *(const f32x4*)(F.in[31] + 8 * F.lane + 512 * j + 4); }
    for (int m0 = row_lo + vw; m0 < row_hi; m0 += 4 * nvw) {
        u32x4 r[4][2]; float rs[4];
#pragma unroll
        for (int q = 0; q < 4; ++q) { const int m = m0 + q * nvw; if (m < row_hi && FSEL(m)) { rs[q] = ss5[m]; r[q][0] = *(const u32x4*)(H4 + (size_t)m * DM + 8 * F.lane); r[q][1] = *(const u32x4*)(H4 + (size_t)m * DM + 8 * F.lane + 512); } }
#pragma unroll
        for (int q = 0; q < 4; ++q) { const int m = m0 + q * nvw; if (m < row_hi && FSEL(m)) { const float sc = rsqrtf(rs[q] * (1.f / DM) + EPS); float* yp = F.out + (size_t)m * DM;
#pragma unroll
            for (int j = 0; j < 2; ++j) { const int c = 8 * F.lane + 512 * j; const u32x4 t = r[q][j];
                *(f32x4*)(yp + c) = (f32x4){bflo(t.x) * sc * g[j][0][0], bfhi(t.x) * sc * g[j][0][1], bflo(t.y) * sc * g[j][0][2], bfhi(t.y) * sc * g[j][0][3]};
                *(f32x4*)(yp + c + 4) = (f32x4){bflo(t.z) * sc * g[j][1][0], bfhi(t.z) * sc * g[j][1][1], bflo(t.w) * sc * g[j][1][2], bfhi(t.w) * sc * g[j][1][3]}; } } }
    }
}
#undef FSEL

constexpr int LDS_BYTES = 147456;
__global__ void __launch_bounds__(512, 2) fwd_kernel(Args args) {
    extern __shared__ __attribute__((aligned(16))) unsigned char lds[];
    Frame F; F.lds = lds; F.tid = threadIdx.x; F.lane = F.tid & 63; F.wave = __builtin_amdgcn_readfirstlane(F.tid >> 6);
    F.gw = blockIdx.x * 8 + F.wave; F.ngw = gridDim.x * 8; F.in = args.in; F.out = args.out; F.ws = args.ws;
    const int lo = args.ph_lo, hi = args.ph_hi, G = gridDim.x, bid = blockIdx.x;
    volatile LAS unsigned* xb_st = (volatile LAS unsigned*)((LAS unsigned char*)lds + 143360);
    if (threadIdx.x < 4) xb_st[threadIdx.x] = 0u;
    __syncthreads();
    XcdBarrier xbar; xbar.bar = (unsigned*)(args.ws + WS_BAR); xbar.x = 0; xbar.st = nullptr;
    if (hi - lo > 1) xbar = xcd_barrier_post((unsigned*)(args.ws + WS_BAR), xb_st);
    LAS unsigned char* lds3 = (LAS unsigned char*)lds;
    unsigned char* ws = args.ws;
    float* SS = (float*)(ws + WS_CTL);
    bf16_t* HB = (bf16_t*)(ws + WS_HB); bf16_t* ACT = (bf16_t*)(ws + WS_ACT); float* H = args.out;
#ifdef ONLY_PHASE
#define IN(k) ((k) == ONLY_PHASE && lo <= (k) && (k) < hi)
#else
#define IN(k) (lo <= (k) && (k) < hi)
#endif
#define SEAM(k) do { if ((k) + 1 < hi) { if ((k) == 0) cg::this_grid().sync(); else xcd_barrier(xbar); } } while (0)
#ifndef PROBE_DUP
#define PROBE_DUP 0
#endif
#define REP(k) for (int rep_ = 0; rep_ < (((PROBE_DUP >> (k)) & 1) ? 2 : 1); ++rep_)
    if ((PROBE_DUP >> 20) & 1) { for (int i_ = 0; i_ < 20; ++i_) cg::this_grid().sync(); }
    if (IN(0)) { REP(0) { p0_range(F, 0, 2 * I_G, F.gw, F.ngw); p0_xb(F); } SEAM(0);
        if (hi > 1 && F.wave == 0) {
            const unsigned c = F.lane < 16 ? xb_ld(&xbar.bar[XB_XCNT(F.lane)]) : 0u;
            unsigned sum = c;
#pragma unroll
            for (int o = 1; o < 16; o <<= 1) sum += __shfl_xor(sum, o);
            const unsigned cnt = (unsigned)__builtin_popcountll(__ballot(c > 0u)), mine = __shfl(c, (int)xbar.x);
            if (F.lane == 0 && sum == (unsigned)G && mine > 0u) { xb_st[0] = mine; xb_st[1] = cnt; }
        }
    }
    if (IN(1)) { pg8::Gemm g{HB, (const bf16_t*)(ws + WS_WGU1), MT, 2 * FF, DM, 0}; pg8::StaticOrder S; S.init(MT, 2 * FF, G, bid); EpiGU E{SS, ACT}; REP(1) pg8::gemm_phase(lds3, g, S, E);
        { int e, ne; if (tail_idle(S.nwg, G, bid, e, ne)) p0_range(F, 2 * I_G, 3 * I_G, e * 8 + F.wave, ne * 8); } SEAM(1); }
    if (IN(2)) { pg8::Gemm g{ACT, (const bf16_t*)(ws + WS_WD1), MT, DM, FF, 1}; pg8::StaticOrder S; S.init(MT, DM, G, bid); EpiDown<false> E{nullptr, nullptr, HB, SS + MT, 0.5f, nullptr}; pg8::gemm_phase(lds3, g, S, E);
        { int e, ne; if (tail_idle(S.nwg, G, bid, e, ne)) { p0_range(F, 3 * I_G, NITEMS, e * 8 + F.wave, ne * 8); p0_dtcols(F, e * 8 + F.wave, ne * 8); } } SEAM(2); }
    if (IN(3)) { pg8::Gemm g{HB, (const bf16_t*)(ws + WS_WIN), MT, NIN, DM, 0}; pg8::StaticOrder S; S.init(MT, NIN, G, bid);
        EpiIn E{SS + MT, (bf16_t*)(ws + WS_AC), (bf16_t*)(ws + WS_M), (bf16_t*)(ws + WS_XBC), (float*)(ws + WS_DTR)}; REP(3) pg8::gemm_phase(lds3, g, S, E); SEAM(3); }
    if (IN(4)) { REP(4) s0_phase(F); SEAM(4); }
    if (IN(5)) { REP(5) for (int u = bid; u < NCH * 2; u += G) s1_unit(F, u); SEAM(5); }
    if (IN(6)) { if ((PROBE_DUP >> 6) & 1) s2_phase<true>(F); s2_phase<false>(F); SEAM(6); }
    if (IN(7)) { if ((PROBE_DUP >> 7) & 1) for (int u = bid; u < NCH * 2; u += G) s3_unit<true>(F, u); for (int u = bid; u < NCH * 2; u += G) s3_unit<false>(F, u); SEAM(7); }
    if (IN(8)) { cvt_pb(F); REP(14) cv_phase(F); SEAM(8); }
    if (IN(9)) { pg8::Gemm g{(const bf16_t*)(ws + WS_M), (const bf16_t*)(ws + WS_WOUT), MT, DM, 2048, 0}; pg8::StaticOrder S; S.init(MT, DM, G, bid);
        if ((PROBE_DUP >> 9) & 1) { EpiDown<false> E0{nullptr, nullptr, HB, SS + 6 * MT, 0.0f, SS + 5 * MT}; pg8::gemm_phase(lds3, g, S, E0); }
        EpiDown<false> E{nullptr, nullptr, HB, SS + 2 * MT, 1.0f, SS + 5 * MT}; pg8::gemm_phase(lds3, g, S, E);
        { int e, ne; if (tail_idle(S.nwg, G, bid, e, ne)) { __syncthreads(); pg8::Gemm g2{(const bf16_t*)(ws + WS_PB), (const bf16_t*)(ws + WS_WPP), MT, DM, 256, 0}; pg8::StaticOrder S2; S2.init(MT, DM, ne, e); EpiProj E2{(bf16_t*)(ws + WS_PROJ)}; pg8::gemm_phase(lds3, g2, S2, E2); } }
        SEAM(9); }
    if (IN(10)) { pg8::Gemm g{HB, (const bf16_t*)(ws + WS_WGU2), MT, 2 * FF, DM, 0}; pg8::StaticOrder S; S.init(MT, 2 * FF, G, bid); EpiGU E{SS + 2 * MT, ACT}; pg8::gemm_phase(lds3, g, S, E); SEAM(10); }
    const int nsb = G >= 64 ? 16 : 1;
    int ple_full, ple_rem;
    { const int nw = (NPR / 256) * (DM / 256); ple_full = (nw / (G - nsb)) * (G - nsb); ple_rem = nw - ple_full;
      if (ple_rem > G - nsb - 8) { ple_full = nw; ple_rem = 0; } }
#define PLE_MASK(m0_, m1_) unsigned long long m0_ = 0ull, m1_ = 0ull; { pg8::StaticOrder S_; S_.init(NPR, DM, G - nsb, 0, 0); \
      for (int L_ = ple_full; L_ < S_.nwg; ++L_) { const int pm_ = S_.panel_of(L_); if (pm_ < 64) m0_ |= 1ull << pm_; else m1_ |= 1ull << (pm_ - 64); } }
    if (IN(11)) { pg8::Gemm g{ACT, (const bf16_t*)(ws + WS_WD2), MT, DM, FF, 1}; pg8::StaticOrder S; S.init(NPR, DM, G, bid, 0); EpiDown<false> E{nullptr, nullptr, HB, SS + 3 * MT, 0.5f, nullptr}; pg8::gemm_phase(lds3, g, S, E); SEAM(11); }
    if (IN(12)) {
        if (bid < nsb) { pg8::Gemm g{ACT, (const bf16_t*)(ws + WS_WD2), MT, DM, FF, 1}; pg8::StaticOrder S; S.init(NSM, DM, nsb, bid, NPR / 256); EpiDown<false> E{nullptr, nullptr, HB, SS + 3 * MT, 0.5f, nullptr}; pg8::gemm_phase(lds3, g, S, E); }
        else { pg8::Gemm g{HB, (const bf16_t*)(ws + WS_WPG), MT, DM, DM, 0}; pg8::StaticOrder S; S.init(NPR, DM, G - nsb, bid - nsb, 0); S.Lend = ple_full;
            EpiPle E{SS + 3 * MT, (const bf16_t*)(ws + WS_PROJ), HB, ACT, SS + 4 * MT, 1.f}; pg8::gemm_phase(lds3, g, S, E); }
        SEAM(12);
    }
    if (IN(13)) {
        if (bid < nsb) { pg8::Gemm g{HB, (const bf16_t*)(ws + WS_WPG), MT, DM, DM, 0}; pg8::StaticOrder S; S.init(NSM, DM, nsb, bid, NPR / 256); EpiPle E{SS + 3 * MT, (const bf16_t*)(ws + WS_PROJ), HB, ACT, SS + 4 * MT, 1.f}; pg8::gemm_phase(lds3, g, S, E); }
        else if (bid < nsb + ple_rem) { pg8::Gemm g{HB, (const bf16_t*)(ws + WS_WPG), MT, DM, DM, 0}; pg8::StaticOrder S; S.init(NPR, DM, ple_rem, bid - nsb, 0); S.Lbase = ple_full;
            EpiPle E{SS + 3 * MT, (const bf16_t*)(ws + WS_PROJ), HB, ACT, SS + 4 * MT, 1.f}; pg8::gemm_phase(lds3, g, S, E); }
        else { PLE_MASK(pmk0, pmk1); final_phase<false>(F, 0, NPR, (bid - nsb - ple_rem) * 8 + F.wave, (G - nsb - ple_rem) * 8, 1, pmk0, pmk1); }
        SEAM(13);
    }
    if (IN(14)) { PLE_MASK(pmk0, pmk1); final_phase<false>(F, 0, MT, F.gw, F.ngw, 2, pmk0, pmk1); }
#undef PLE_MASK
#undef IN
#undef SEAM
}

extern "C" void kernel_launch(void* const* d_in, const int* in_sizes, int n_in, void* d_out, int out_size, void* d_ws, size_t ws_size, hipStream_t stream) {
    static int grid = 0;
    if (grid == 0) {
        if (n_in != 32 || out_size != (int)O_END || ws_size < WS_END) { fprintf(stderr, "kernel_launch: unexpected shapes: n_in %d out %d ws %zu\n", n_in, out_size, ws_size); grid = -1; return; }
        int dev = 0, cus = 0, per_cu = 0;
        hipGetDevice(&dev); hipDeviceGetAttribute(&cus, hipDeviceAttributeMultiprocessorCount, dev);
        if (hipFuncSetAttribute((const void*)fwd_kernel, hipFuncAttributeMaxDynamicSharedMemorySize, LDS_BYTES) != hipSuccess) { fprintf(stderr, "kernel_launch: hipFuncSetAttribute failed\n"); grid = -1; return; }
        if (hipOccupancyMaxActiveBlocksPerMultiprocessor(&per_cu, (const void*)fwd_kernel, 512, LDS_BYTES) != hipSuccess || per_cu < 1) { fprintf(stderr, "kernel_launch: occupancy query failed (%d)\n", per_cu); grid = -1; (void)hipGetLastError(); return; }
        grid = cus * 1;
        fprintf(stderr, "kernel_launch: cus %d per_cu %d grid %d\n", cus, per_cu, grid);
    }
    if (grid < 0) return;
    hipMemsetAsync((char*)d_ws + WS_CTL, 0, CTL_BYTES, stream);
    Args a{};
    for (int i = 0; i < 32; ++i) a.in[i] = (const float*)d_in[i];
    a.out = (float*)d_out; a.ws = (unsigned char*)d_ws;
#if MK_LAUNCHES == 1
    a.ph_lo = 0; a.ph_hi = NPH;
    void* kargs[] = {&a};
    hipError_t e = hipLaunchCooperativeKernel((const void*)fwd_kernel, dim3(grid), dim3(512), kargs, LDS_BYTES, stream);
    if (e != hipSuccess) fprintf(stderr, "kernel_launch: cooperative launch failed: %s\n", hipGetErrorString(e));
#else
    for (int p = 0; p < NPH; ++p) { a.ph_lo = p; a.ph_hi = p + 1; hipLaunchKernelGGL(fwd_kernel, dim3(grid), dim3(512), LDS_BYTES, stream, a); }
#endif
}
```
